# Optimizing an MI355X kernel written in HIP

```python
import math
import jax, jax.numpy as jnp
from jax import lax
import numpy as np

D_MODEL = 2048
BATCH = 2
SEQ = 4096
DEPTH = 1

CTX_LEN = 256
GRID_W = 64
MIX_WIDTH = D_MODEL
ATTN_WIDTH = MIX_WIDTH // 2
CONV_WIDTH = MIX_WIDTH - ATTN_WIDTH
HEAD_DIM = 128
N_HEADS = ATTN_WIDTH // HEAD_DIM
N_KV_HEADS = 2
GROUP = N_HEADS // N_KV_HEADS
KV_WIDTH = N_KV_HEADS * HEAD_DIM
CONV_GROUPS = CONV_WIDTH // HEAD_DIM
CONV_K = 3
Q_BLOCK = 128
ROPE_THETA = 10000.0
EPS = 1e-6
IN_COLS = ATTN_WIDTH + 2 * KV_WIDTH + ATTN_WIDTH + 4 * CONV_WIDTH

kernel_name = "hybrid_gqa_shortconv_dit_layer"


def rms_norm(x, g):
    xf = x.astype(jnp.float32)
    y = xf * lax.rsqrt(jnp.mean(xf * xf, axis=-1, keepdims=True) + EPS)
    return (y * g.astype(jnp.float32)).astype(x.dtype)


def adaln_params(cond, w_mod, b_mod):
    m = jax.nn.silu(cond) @ w_mod + b_mod
    return jnp.split(m, 3, axis=-1)


def axial_rope(x, row, col):
    half = HEAD_DIM // 2
    quarter = half // 2
    inv = ROPE_THETA ** (-jnp.arange(quarter, dtype=jnp.float32) / quarter)

    def rot(xa, pos):
        ang = pos.astype(jnp.float32)[:, None] * inv[None, :]
        cos = jnp.cos(ang)[None, :, None, :]
        sin = jnp.sin(ang)[None, :, None, :]
        xa = xa.astype(jnp.float32)
        x1, x2 = xa[..., :quarter], xa[..., quarter:]
        return jnp.concatenate([x1 * cos - x2 * sin, x2 * cos + x1 * sin], axis=-1)

    out = jnp.concatenate([rot(x[..., :half], row), rot(x[..., half:], col)], axis=-1)
    return out.astype(x.dtype)


def short_conv(u, w):
    L = u.shape[1]
    up = jnp.pad(u, ((0, 0), (1, 1), (0, 0)))
    return up[:, :L] * w[0] + up[:, 1:L + 1] * w[1] + up[:, 2:] * w[2]


def split_proj(p):
    sizes = [ATTN_WIDTH, KV_WIDTH, KV_WIDTH, ATTN_WIDTH,
             CONV_WIDTH, CONV_WIDTH, CONV_WIDTH, CONV_WIDTH]
    idx = np.cumsum(sizes)[:-1].tolist()
    return jnp.split(p, idx, axis=-1)


def qk_heads(q, k, v, q_g, k_g):
    B, L = q.shape[:2]
    q = rms_norm(q.reshape(B, L, N_HEADS, HEAD_DIM), q_g)
    k = rms_norm(k.reshape(B, L, N_KV_HEADS, HEAD_DIM), k_g)
    v = v.reshape(B, L, N_KV_HEADS, HEAD_DIM)
    return q, k, v


def latent_attention(q, k_lat, v_lat, k_ctx, v_ctx):
    B, S = q.shape[:2]
    scale = 1.0 / math.sqrt(HEAD_DIM)
    k_all = jnp.concatenate([k_ctx, k_lat], axis=1)
    v_all = jnp.concatenate([v_ctx, v_lat], axis=1)
    n_blk = S // Q_BLOCK
    qb = q.reshape(B, n_blk, Q_BLOCK, N_KV_HEADS, GROUP, HEAD_DIM).transpose(1, 0, 3, 4, 2, 5)

    def one_block(q_blk):
        s = jnp.einsum('bkgqd,bskd->bkgqs', q_blk, k_all).astype(jnp.float32) * scale
        p = jax.nn.softmax(s, axis=-1).astype(v_all.dtype)
        return jnp.einsum('bkgqs,bskd->bkgqd', p, v_all)

    o = lax.map(one_block, qb)
    return o.transpose(1, 0, 4, 2, 3, 5).reshape(B, S, ATTN_WIDTH)


def context_attention(q, k, v):
    B, L = q.shape[:2]
    scale = 1.0 / math.sqrt(HEAD_DIM)
    qg = q.reshape(B, L, N_KV_HEADS, GROUP, HEAD_DIM)
    s = jnp.einsum('bqkgd,bskd->bkgqs', qg, k).astype(jnp.float32) * scale
    p = jax.nn.softmax(s, axis=-1).astype(v.dtype)
    o = jnp.einsum('bkgqs,bskd->bqkgd', p, v)
    return o.reshape(B, L, ATTN_WIDTH)


def conv_branch(b, cg, h, gate_c, w):
    return jax.nn.silu(gate_c) * (b * short_conv(cg * h, w))


def setup_inputs(seed: int = 0) -> dict:
    key = jax.random.key(seed)
    ks = jax.random.split(key, 13)
    D = D_MODEL
    x = jax.random.normal(ks[0], (BATCH, SEQ, D), jnp.float32)
    c = jax.random.normal(ks[1], (BATCH, D), jnp.float32)
    ctx = jax.random.normal(ks[2], (BATCH, CTX_LEN, D), jnp.float32)
    c_ctx = 0.5 * jax.random.normal(ks[3], (D,), jnp.float32)
    w_mod = 0.3 * D ** -0.5 * jax.random.normal(ks[4], (DEPTH, D, 3 * D), jnp.float32)
    b_mod = 0.02 * jax.random.normal(ks[5], (DEPTH, 3 * D), jnp.float32)
    norm_g = 1.0 + 0.02 * jax.random.normal(ks[6], (DEPTH, D), jnp.float32)
    w_in = D ** -0.5 * jax.random.normal(ks[7], (DEPTH, D, IN_COLS), jnp.float32)
    q_norm_g = 1.0 + 0.02 * jax.random.normal(ks[8], (DEPTH, HEAD_DIM), jnp.float32)
    k_norm_g = 1.0 + 0.02 * jax.random.normal(ks[9], (DEPTH, HEAD_DIM), jnp.float32)
    conv_w = CONV_K ** -0.5 * jax.random.normal(ks[10], (DEPTH, CONV_K, CONV_WIDTH), jnp.float32)
    w_out = MIX_WIDTH ** -0.5 * jax.random.normal(ks[11], (DEPTH, MIX_WIDTH, D), jnp.float32)
    final_norm_g = 1.0 + 0.02 * jax.random.normal(ks[12], (D,), jnp.float32)
    return {"x": x, "c": c, "ctx": ctx, "c_ctx": c_ctx, "w_mod": w_mod, "b_mod": b_mod,
            "norm_g": norm_g, "w_in": w_in, "q_norm_g": q_norm_g, "k_norm_g": k_norm_g,
            "conv_w": conv_w, "w_out": w_out, "final_norm_g": final_norm_g}


def reference(x, c, ctx, c_ctx, w_mod, b_mod, norm_g, w_in, q_norm_g, k_norm_g,
              conv_w, w_out, final_norm_g):
    S = x.shape[1]
    ROWS = S // GRID_W
    row = jnp.repeat(jnp.arange(ROWS, dtype=jnp.int32), GRID_W)
    col = jnp.tile(jnp.arange(GRID_W, dtype=jnp.int32), ROWS)

    for layer in range(DEPTH):
        shift, scale, gate = adaln_params(c, w_mod[layer], b_mod[layer])
        shift_c, scale_c, gate_c = adaln_params(c_ctx, w_mod[layer], b_mod[layer])

        h_ctx = rms_norm(ctx, norm_g[layer]) * (1.0 + scale_c) + shift_c
        qc, kc, vc, ga_c, b_c, cg_c, hh_c, gc_c = split_proj(h_ctx @ w_in[layer])
        qc, kc, vc = qk_heads(qc, kc, vc, q_norm_g[layer], k_norm_g[layer])

        h = rms_norm(x, norm_g[layer]) * (1.0 + scale[:, None, :]) + shift[:, None, :]
        q, k, v, ga, b, cg, hh, gc = split_proj(h @ w_in[layer])
        q, k, v = qk_heads(q, k, v, q_norm_g[layer], k_norm_g[layer])
        q = axial_rope(q, row, col)
        k = axial_rope(k, row, col)
        attn = jax.nn.silu(ga) * latent_attention(q, k, v, kc, vc)
        conv = conv_branch(b, cg, hh, gc, conv_w[layer])
        y = jnp.concatenate([attn, conv], axis=-1) @ w_out[layer]
        x = x + gate[:, None, :] * y

        if layer < DEPTH - 1:
            attn_c = jax.nn.silu(ga_c) * context_attention(qc, kc, vc)
            conv_c = conv_branch(b_c, cg_c, hh_c, gc_c, conv_w[layer])
            y_c = jnp.concatenate([attn_c, conv_c], axis=-1) @ w_out[layer]
            ctx = ctx + gate_c * y_c

    return rms_norm(x, final_norm_g)
```

```cpp
#include <hip/hip_runtime.h>
#include <hip/hip_cooperative_groups.h>
#include <cstdio>
#include <cstdint>
namespace cg = cooperative_groups;

#define LAS __attribute__((address_space(3)))
typedef unsigned short bf16_t;
typedef short bf16x8 __attribute__((ext_vector_type(8)));
typedef short s16x4 __attribute__((ext_vector_type(4)));
typedef float f32x2 __attribute__((ext_vector_type(2)));
typedef float f32x4 __attribute__((ext_vector_type(4)));
typedef float f32x16 __attribute__((ext_vector_type(16)));
typedef unsigned u32x2 __attribute__((ext_vector_type(2)));
typedef unsigned u32x4 __attribute__((ext_vector_type(4)));

constexpr int DM = 2048, NB = 2, SEQ = 4096, CTX = 256, MLAT = NB * SEQ, MCTX = NB * CTX, MALL = MLAT + MCTX;
constexpr int NIN = 6656, HD = 128, NH = 8, NKV = 2, SKV = CTX + SEQ, AW = 1024, CW = 1024;
constexpr float EPS = 1e-6f;
constexpr float QSCALE_F = 0.088388347648318440f * 1.4426950408889634f;
constexpr int NWAVES = 8, NTHREADS = 512;

constexpr size_t MiB = 1u << 20;
constexpr size_t WS_PART = 0;
constexpr size_t WS_BAR  = 768 * 1024;
constexpr int PANEL_CNT_WORD = 4096, TT_QUEUE_WORD = 7168; constexpr size_t CTL_BYTES = 32768;
constexpr size_t WS_GATE = 1 * MiB;
constexpr size_t WS_SSQ  = 2 * MiB;
constexpr size_t WS_WIN  = 4 * MiB;
constexpr size_t WS_WOUT = 30 * MiB;
constexpr size_t WS_H    = 38 * MiB;
constexpr size_t WS_Q    = 72 * MiB;
constexpr size_t WS_K    = 88 * MiB;
constexpr size_t WS_V    = 93 * MiB;
constexpr size_t WS_GA   = 98 * MiB;
constexpr size_t WS_U    = 114 * MiB;
constexpr size_t WS_G    = 130 * MiB;
constexpr size_t WS_MIX  = 146 * MiB;
constexpr size_t WS_END  = 178 * MiB;

constexpr int RING_BYTES = 131072, XCH_OFF = RING_BYTES, MISC_OFF = XCH_OFF + 12288, LDS_BYTES = 147456;

__device__ __forceinline__ unsigned cvt_pk_bf16(float lo, float hi) { unsigned r; asm volatile("v_cvt_pk_bf16_f32 %0, %1, %2" : "=v"(r) : "v"(lo), "v"(hi)); return r; }
__device__ __forceinline__ float bf2f(unsigned short h) { return __builtin_bit_cast(float, (unsigned)h << 16); }
__device__ __forceinline__ float bflo(unsigned w) { return __builtin_bit_cast(float, w << 16); }
__device__ __forceinline__ float bfhi(unsigned w) { return __builtin_bit_cast(float, w & 0xffff0000u); }
__device__ __forceinline__ float silu_f(float x) { return x * __builtin_amdgcn_rcpf(1.f + __builtin_amdgcn_exp2f(-1.4426950408889634f * x)); }
__device__ __forceinline__ float silu_acc(float x) { return x / (1.f + __expf(-x)); }
__device__ __forceinline__ float wave_sum(float v) {
#pragma unroll
    for (int o = 1; o < 64; o <<= 1) v += __shfl_xor(v, o);
    return v;
}
__device__ __forceinline__ int opaque_tid(int wave_s) { int l = __builtin_amdgcn_mbcnt_hi(~0u, __builtin_amdgcn_mbcnt_lo(~0u, 0u)); asm volatile("" : "+v"(l)); return wave_s * 64 + l; }
template <int N> __device__ __forceinline__ float row_ror(float v) { return __builtin_bit_cast(float, __builtin_amdgcn_update_dpp(0, __builtin_bit_cast(int, v), 0x120 + N, 0xf, 0xf, false)); }
#define LDS_WAIT() asm volatile("s_waitcnt lgkmcnt(0)" ::: "memory")

namespace pg8 {
constexpr int BM = 256, BK = 64, HALF = 128, HTB = HALF * BK * 2, STAGE_BYTES = 8 * HTB, NXCD = 8, WGM = 8;
__host__ __device__ __forceinline__ int lds_byte(int r, int c) { const int st = (r >> 4) * 2 + (c >> 5), rr = r & 15, cc = c & 31, ob = rr * 64 + cc * 2; return st * 1024 + (ob ^ (((ob >> 9) & 1) << 5)); }
__host__ __device__ __forceinline__ void stage_rc(int b, int& R, int& C) { const int st = b / 1024, sb = b % 1024, swz = sb ^ (((sb >> 9) & 1) << 5); R = (st >> 1) * 16 + swz / 64; C = (st & 1) * 32 + (swz % 64) / 2; }
__host__ __device__ __forceinline__ int perm32(int rho) { const int n = rho >> 4, i = rho & 15; return 8 * (i >> 2) + 4 * n + (i & 3); }

struct Unit { int pm, pn; };
struct Gemm { const bf16_t* A; const bf16_t* Bt; int M, N, K; };

template <int NM, int NN, int EXTRA = 0, int EPM0 = 0, int EPN0 = 0, int ENN = 1>
struct TileMap {
    static constexpr int nwg = NM * NN, ntot = nwg + EXTRA;
    __device__ static __forceinline__ void decode(int ui, Unit& u) {
        if (EXTRA > 0 && ui >= nwg) { const int j = ui - nwg; u.pm = EPM0 + j / ENN; u.pn = EPN0 + j % ENN; return; }
        int wgid = ui; { constexpr int q = nwg / NXCD, r = nwg % NXCD; const int xcd = wgid % NXCD, off = wgid / NXCD; wgid = (xcd < r ? xcd * (q + 1) : r * (q + 1) + (xcd - r) * q) + off; }
        constexpr int nig = WGM * NN; const int gid = wgid / nig, fm = gid * WGM, gsz = (NM - fm) < WGM ? (NM - fm) : WGM;
        u.pm = fm + ((wgid % nig) % gsz); u.pn = (wgid % nig) / gsz;
    }
};
template <class Map> struct StaticOrder {
    int G, c, limit;
    __device__ __forceinline__ void init(int G_, int c_, int limit_) { G = G_; c = c_; limit = limit_; }
    __device__ __forceinline__ bool next(int i, Unit& u) const { const int L = i * G + c; if (L >= limit) return false; Map::decode(L, u); return true; }
};
template <class Map> struct OneUnit {
    int ui;
    __device__ __forceinline__ bool next(int i, Unit& u) const { if (i != 0 || ui < 0) return false; Map::decode(ui, u); return true; }
};

template <class Epi, class Sched, int RH = -1, bool PROLOGUE = true, bool DRAIN = true>
__device__ __forceinline__ void gemm_phase(LAS unsigned char* lds, const Gemm g, const Sched& S, const Epi& E, int wave_s, const Unit* handoff = nullptr) {
    const int tid = opaque_tid(wave_s), wid = wave_s, lane = tid & 63, wr = wid >> 2, wc = wid & 3, fr = lane & 15, fq = lane >> 4;
    const int K = g.K, nt = K / BK;
    unsigned voffA[2], voffB[2];
#pragma unroll
    for (int i = 0; i < 2; ++i) { int R, C; stage_rc(tid * 16 + i * 8192, R, C); const int Rb = (R & ~31) + perm32(R & 31);
        voffA[i] = (unsigned)(R * K + C) * 2u; voffB[i] = (unsigned)(Rb * K + C) * 2u; }
    const size_t kstep = (size_t)(BK * 2);
    const size_t hstep = (size_t)HALF * K * 2;
    const size_t tstep = 2 * hstep;
    const unsigned ldsw = (unsigned)wid * 1024u;
    const int aoff = lds_byte(wr * 64 + fr, fq * 8), boff = lds_byte(wc * 32 + fr, fq * 8);
#define PG8_SA(b, h) (((b) * 2 + (h)) * HTB)
#define PG8_SB(b, h) ((4 + (b) * 2 + (h)) * HTB)
#define PG8_STAGE(bufoff, gbase, voff) do { _Pragma("unroll") for (int _i = 0; _i < 2; ++_i) \
        __builtin_amdgcn_global_load_lds((const unsigned*)((const char*)(gbase) + (voff)[_i]), (LAS unsigned*)(lds + (bufoff) + ldsw + _i * 8192), 16, 0, 0); } while (0)
#define PG8_LDA(dst, b, h) do { _Pragma("unroll") for (int m = 0; m < 4; ++m) _Pragma("unroll") for (int k = 0; k < 2; ++k) dst[m][k] = *(const LAS bf16x8*)(lds + PG8_SA(b, h) + aoff + m * 2048 + k * 1024); } while (0)
#define PG8_LDB(dst, b, h) do { _Pragma("unroll") for (int n = 0; n < 2; ++n) _Pragma("unroll") for (int k = 0; k < 2; ++k) dst[n][k] = *(const LAS bf16x8*)(lds + PG8_SB(b, h) + boff + n * 2048 + k * 1024); } while (0)
#define PG8_MMA(ai, bj, At, Bt) do { __builtin_amdgcn_s_setprio(1); _Pragma("unroll") for (int m = 0; m < 4; ++m) _Pragma("unroll") for (int n = 0; n < 2; ++n) _Pragma("unroll") for (int k = 0; k < 2; ++k) \
        acc[ai][bj][m][n] = __builtin_amdgcn_mfma_f32_16x16x32_bf16(Bt[n][k], At[m][k], acc[ai][bj][m][n], 0, 0, 0); __builtin_amdgcn_s_setprio(0); } while (0)
#define PG8_WAIT_V(n) asm volatile("s_waitcnt vmcnt(" #n ")" ::: "memory")
#define PG8_WAIT_L(n) asm volatile("s_waitcnt lgkmcnt(" #n ")" ::: "memory")
#define PG8_BAR __builtin_amdgcn_s_barrier()
#define PG8_SCHED __builtin_amdgcn_sched_barrier(0)
    Unit cur, nxt; int ui = 0;
    if (!S.next(0, cur)) return;
    f32x4 acc[2][2][4][2];
#pragma unroll
    for (int a = 0; a < 2; ++a)
#pragma unroll
        for (int b = 0; b < 2; ++b)
#pragma unroll
            for (int m = 0; m < 4; ++m)
#pragma unroll
                for (int n = 0; n < 2; ++n) acc[a][b][m][n] = (f32x4){0.f, 0.f, 0.f, 0.f};
    bf16x8 At[4][2], B0[2][2], B1[2][2];
    const char* cA = (const char*)g.A + (size_t)cur.pm * tstep; const char* cB = (const char*)g.Bt + (size_t)cur.pn * tstep;
    if constexpr (PROLOGUE) {
    PG8_STAGE(PG8_SB(0, 0), cB, voffB); PG8_STAGE(PG8_SB(0, 1), cB + hstep, voffB); PG8_STAGE(PG8_SA(0, 0), cA, voffA); PG8_STAGE(PG8_SA(0, 1), cA + hstep, voffA);
    if (wr == 1) PG8_BAR;
    PG8_WAIT_V(2); PG8_BAR;
    PG8_STAGE(PG8_SB(1, 0), cB + kstep, voffB); PG8_STAGE(PG8_SA(1, 0), cA + kstep, voffA); PG8_STAGE(PG8_SB(1, 1), cB + hstep + kstep, voffB);
    PG8_WAIT_V(6); PG8_BAR;
    }
    for (;;) {
        const bool has_next = S.next(ui + 1, nxt);
        constexpr bool do0 = RH != 1, do1 = RH != 0;
        const bool chain = !has_next && !DRAIN && handoff != nullptr;
        const Unit pre = chain ? *handoff : nxt; const bool has_pref = has_next || chain;
        const char* nA = has_pref ? (const char*)g.A + (size_t)pre.pm * tstep : cA; const char* nB = has_pref ? (const char*)g.Bt + (size_t)pre.pn * tstep : cB;
        for (int t = 0; t < nt; t += 2) {
            const bool last = (t == nt - 2);
            const char* a1 = cA + (size_t)(t + 1) * kstep;
            const char* a2 = last ? nA : cA + (size_t)(t + 2) * kstep; const char* b2 = last ? nB : cB + (size_t)(t + 2) * kstep;
            const char* a3 = a2 + kstep; const char* b3 = b2 + kstep;
            PG8_LDB(B0, 0, 0); PG8_LDB(B1, 0, 1); PG8_SCHED; if (do0) PG8_LDA(At, 0, 0); PG8_STAGE(PG8_SA(1, 1), a1 + hstep, voffA);
            PG8_WAIT_V(8); PG8_WAIT_L(0); PG8_BAR; if (do0) { PG8_MMA(0, 0, At, B0); PG8_MMA(0, 1, At, B1); } PG8_BAR; PG8_SCHED;
            if (do1) PG8_LDA(At, 0, 1); PG8_STAGE(PG8_SB(0, 0), b2, voffB); PG8_STAGE(PG8_SB(0, 1), b2 + hstep, voffB); PG8_STAGE(PG8_SA(0, 0), a2, voffA);
            PG8_WAIT_V(8); PG8_WAIT_L(0); PG8_BAR; if (do1) { PG8_MMA(1, 0, At, B0); PG8_MMA(1, 1, At, B1); } PG8_BAR; PG8_SCHED;
            PG8_LDB(B0, 1, 0); PG8_LDB(B1, 1, 1); PG8_SCHED; if (do0) PG8_LDA(At, 1, 0); PG8_STAGE(PG8_SA(0, 1), a2 + hstep, voffA);
            PG8_WAIT_V(8); PG8_WAIT_L(0); PG8_BAR; if (do0) { PG8_MMA(0, 0, At, B0); PG8_MMA(0, 1, At, B1); } PG8_BAR; PG8_SCHED;
            if (do1) PG8_LDA(At, 1, 1); PG8_STAGE(PG8_SB(1, 0), b3, voffB); PG8_STAGE(PG8_SB(1, 1), b3 + hstep, voffB); PG8_STAGE(PG8_SA(1, 0), a3, voffA);
            PG8_WAIT_V(8); PG8_WAIT_L(0); PG8_BAR; if (do1) { PG8_MMA(1, 0, At, B0); PG8_MMA(1, 1, At, B1); } PG8_BAR; PG8_SCHED;
        }
        if (wr == 0) PG8_BAR;
        E.template run<RH>(acc, cur, wr, wc, fr, fq);
        if (!has_next) break;
#pragma unroll
        for (int a = 0; a < 2; ++a)
#pragma unroll
            for (int b = 0; b < 2; ++b)
#pragma unroll
                for (int m = 0; m < 4; ++m)
#pragma unroll
                    for (int n = 0; n < 2; ++n) acc[a][b][m][n] = (f32x4){0.f, 0.f, 0.f, 0.f};
        cur = nxt; cA = nA; cB = nB; ++ui;
        if (wr == 1) PG8_BAR;
    }
    if constexpr (DRAIN) { PG8_WAIT_V(0); PG8_BAR; }
    else { if (handoff != nullptr) { if (wr == 1) PG8_BAR; } else { PG8_WAIT_V(0); PG8_BAR; } }
#undef PG8_SA
#undef PG8_SB
#undef PG8_STAGE
#undef PG8_LDA
#undef PG8_LDB
#undef PG8_MMA
#undef PG8_WAIT_V
#undef PG8_WAIT_L
#undef PG8_BAR
#undef PG8_SCHED
}
}

__host__ __device__ __forceinline__ int win_src_col(int n) {
    if (n < 1280) { const int hb = n & ~127, s = n & 127, p = s >> 1, e = s & 1; return hb + (p < 32 ? p : p + 32) + 32 * e; }
    if (n < 2560) return n;
    const int t = n - 2560, ct = t >> 8, w = t & 255, half = w >> 7, s = w & 127, ch = ct * 64 + (s >> 1), e = s & 1;
    const int sec = half == 0 ? (e == 0 ? 3584 : 4608) : (e == 0 ? 2560 : 5632);
    return sec + ch;
}
struct EpiIn {
    unsigned char* ws; const float *qg, *kg, *convw; LAS float* P;
    template <int RH> __device__ __forceinline__ void run(f32x4 (&acc)[2][2][4][2], const pg8::Unit& u, int wr, int wc, int fr, int fq) const {
        asm volatile("" : "+v"(fr), "+v"(fq));
        const int pn = u.pn, pm = u.pm;
        bf16_t* const Q = (bf16_t*)(ws + WS_Q); bf16_t* const KB = (bf16_t*)(ws + WS_K); bf16_t* const VB = (bf16_t*)(ws + WS_V);
        bf16_t* const GA = (bf16_t*)(ws + WS_GA); bf16_t* const U = (bf16_t*)(ws + WS_U); bf16_t* const G = (bf16_t*)(ws + WS_G);
        const int rl0 = wr * 64 + fr;
        const bool isctx = pm >= 32;
        const int kvrow0 = isctx ? (pm - 32) * SKV : (pm >> 4) * SKV + CTX + (pm & 15) * 256;
        if (pn <= 4) {
            const bool isk = (pn == 4);
            const float* gw = isk ? kg : qg;
            float g1[2][2], g2[2][2], invf[2][2];
#pragma unroll
            for (int n = 0; n < 2; ++n)
#pragma unroll
                for (int jj = 0; jj < 2; ++jj) { const int p = 16 * wc + 4 * fq + 2 * n + jj, d1 = p < 32 ? p : p + 32;
                    g1[n][jj] = gw[d1]; g2[n][jj] = gw[d1 + 32]; invf[n][jj] = exp2f(-(float)(p & 31) * 0.41524101186092029f) * 0.15915494309189535f; }
#pragma unroll
            for (int ai = 0; ai < 2; ++ai) if (RH < 0 || ai == RH)
#pragma unroll
                for (int m = 0; m < 4; ++m)
#pragma unroll
                    for (int bj = 0; bj < 2; ++bj) { const f32x4 a = acc[ai][bj][m][0], b = acc[ai][bj][m][1];
                        float s = (a[0] * a[0] + a[1] * a[1]) + (a[2] * a[2] + a[3] * a[3]) + (b[0] * b[0] + b[1] * b[1]) + (b[2] * b[2] + b[3] * b[3]);
                        s += __shfl_xor(s, 16); s += __shfl_xor(s, 32);
                        if (fq == 0) P[((ai * 128 + rl0 + 16 * m) * 2 + bj) * 4 + wc] = s; }
            LDS_WAIT(); __builtin_amdgcn_s_barrier();
            bf16_t* obase; int ld;
            if (isk) { obase = KB + (size_t)kvrow0 * 256; ld = 256; } else { obase = Q + (size_t)pm * 256 * 1024 + pn * 256; ld = 1024; }
#pragma unroll
            for (int ai = 0; ai < 2; ++ai) if (RH < 0 || ai == RH)
#pragma unroll
                for (int m = 0; m < 4; ++m) { const int rl = ai * 128 + rl0 + 16 * m; const int t = (pm & 15) * 256 + rl;
                    const float pos = (float)(wc < 2 ? (t >> 6) : (t & 63));
                    float cs[2][2], sn[2][2];
#pragma unroll
                    for (int n = 0; n < 2; ++n)
#pragma unroll
                        for (int jj = 0; jj < 2; ++jj) { float rev = pos * invf[n][jj]; rev -= floorf(rev);
                            cs[n][jj] = isctx ? 1.f : __builtin_amdgcn_cosf(rev); sn[n][jj] = isctx ? 0.f : __builtin_amdgcn_sinf(rev); }
#pragma unroll
                    for (int bj = 0; bj < 2; ++bj) { const f32x4 pp = *(const LAS f32x4*)(P + (rl * 2 + bj) * 4);
                        const float rstd = rsqrtf(((pp[0] + pp[1]) + (pp[2] + pp[3])) * (1.f / 128.f) + EPS) * (isk ? 1.f : QSCALE_F);
                        unsigned w[4];
#pragma unroll
                        for (int n = 0; n < 2; ++n)
#pragma unroll
                            for (int jj = 0; jj < 2; ++jj) { const float x1 = acc[ai][bj][m][n][2 * jj] * rstd * g1[n][jj], x2 = acc[ai][bj][m][n][2 * jj + 1] * rstd * g2[n][jj];
                                w[2 * n + jj] = cvt_pk_bf16(x1 * cs[n][jj] - x2 * sn[n][jj], x2 * cs[n][jj] + x1 * sn[n][jj]); }
                        *(u32x4*)(obase + (size_t)rl * ld + bj * 128 + 32 * wc + 8 * fq) = (u32x4){w[0], w[1], w[2], w[3]}; } }
        } else if (pn == 5) {
#pragma unroll
            for (int ai = 0; ai < 2; ++ai) if (RH < 0 || ai == RH)
#pragma unroll
                for (int m = 0; m < 4; ++m) { const int rl = ai * 128 + rl0 + 16 * m;
#pragma unroll
                    for (int bj = 0; bj < 2; ++bj) { const f32x4 a = acc[ai][bj][m][0], b = acc[ai][bj][m][1];
                        *(u32x4*)(VB + (size_t)(kvrow0 + rl) * 256 + bj * 128 + 32 * wc + 8 * fq) = (u32x4){cvt_pk_bf16(a[0], a[1]), cvt_pk_bf16(a[2], a[3]), cvt_pk_bf16(b[0], b[1]), cvt_pk_bf16(b[2], b[3])}; } }
        } else if (pn < 10) {
#pragma unroll
            for (int ai = 0; ai < 2; ++ai) if (RH < 0 || ai == RH)
#pragma unroll
                for (int m = 0; m < 4; ++m) { const int rl = ai * 128 + rl0 + 16 * m;
#pragma unroll
                    for (int bj = 0; bj < 2; ++bj) { const f32x4 a = acc[ai][bj][m][0], b = acc[ai][bj][m][1];
                        *(u32x4*)(GA + (size_t)(pm * 256 + rl) * 1024 + (pn - 6) * 256 + bj * 128 + 32 * wc + 8 * fq) =
                            (u32x4){cvt_pk_bf16(silu_f(a[0]), silu_f(a[1])), cvt_pk_bf16(silu_f(a[2]), silu_f(a[3])), cvt_pk_bf16(silu_f(b[0]), silu_f(b[1])), cvt_pk_bf16(silu_f(b[2]), silu_f(b[3]))}; } }
        } else {
            const int cl = 16 * wc + 4 * fq, ch0 = (pn - 10) * 64 + cl;
            bf16_t* const MIXp = (bf16_t*)(ws + WS_MIX);
            float cw0[4], cw1[4], cw2[4];
#pragma unroll
            for (int q = 0; q < 4; ++q) { cw0[q] = convw[ch0 + q]; cw1[q] = convw[CW + ch0 + q]; cw2[q] = convw[2 * CW + ch0 + q]; }
            LAS float* E = P + 2048;
#pragma unroll
            for (int ai = 0; ai < 2; ++ai) if (RH < 0 || ai == RH) {
#pragma unroll
                for (int q = 0; q < 4; ++q) { const f32x4 cf = acc[ai][0][0][q >> 1], cl4 = acc[ai][0][3][q >> 1];
                    if (fr == 0)  E[((ai * 2 + wr) * 2 + 0) * 64 + cl + q] = cf[2 * (q & 1)] * cf[2 * (q & 1) + 1];
                    if (fr == 15) E[((ai * 2 + wr) * 2 + 1) * 64 + cl + q] = cl4[2 * (q & 1)] * cl4[2 * (q & 1) + 1]; } }
            LDS_WAIT(); __builtin_amdgcn_s_barrier(); asm volatile("" ::: "memory");
#pragma unroll
            for (int ai = 0; ai < 2; ++ai) if (RH < 0 || ai == RH) {
                float u[4][4], g[4][4];
#pragma unroll
                for (int m = 0; m < 4; ++m)
#pragma unroll
                    for (int q = 0; q < 4; ++q) { const f32x4 c = acc[ai][0][m][q >> 1], d = acc[ai][1][m][q >> 1];
                        u[m][q] = c[2 * (q & 1)] * c[2 * (q & 1) + 1]; g[m][q] = d[2 * (q & 1)] * silu_f(d[2 * (q & 1) + 1]); }
                float eprev[4], enext[4];
#pragma unroll
                for (int q = 0; q < 4; ++q) { eprev[q] = E[((ai * 2 + 0) * 2 + 1) * 64 + cl + q]; enext[q] = E[((ai * 2 + 1) * 2 + 0) * 64 + cl + q]; }
#pragma unroll
                for (int m = 0; m < 4; ++m) { const int rl = 64 * wr + 16 * m + fr;
                    const size_t row = (size_t)pm * 256 + ai * 128 + rl;
                    float o[4];
#pragma unroll
                    for (int q = 0; q < 4; ++q) {
                        const float sp = row_ror<1>(u[m][q]), spb = (m > 0) ? row_ror<1>(u[m > 0 ? m - 1 : 0][q]) : eprev[q];
                        const float sn = row_ror<15>(u[m][q]), snb = (m < 3) ? row_ror<15>(u[m < 3 ? m + 1 : 3][q]) : enext[q];
                        const float pv = (fr == 0) ? spb : sp, nx = (fr == 15) ? snb : sn;
                        o[q] = g[m][q] * (cw0[q] * pv + cw1[q] * u[m][q] + cw2[q] * nx); }
                    if (rl != 0 && rl != 127) *(u32x2*)(MIXp + row * DM + AW + ch0) = (u32x2){cvt_pk_bf16(o[0], o[1]), cvt_pk_bf16(o[2], o[3])};
                    if (rl <= 1 || rl >= 126) *(u32x2*)(U + row * CW + ch0) = (u32x2){cvt_pk_bf16(u[m][0], u[m][1]), cvt_pk_bf16(u[m][2], u[m][3])};
                    if (rl == 0 || rl == 127) *(u32x2*)(G + row * CW + ch0) = (u32x2){cvt_pk_bf16(g[m][0], g[m][1]), cvt_pk_bf16(g[m][2], g[m][3])}; }
            }
        }
    }
};

__device__ __forceinline__ unsigned xch_ld(unsigned* p)              { return __hip_atomic_load(p, __ATOMIC_RELAXED, __HIP_MEMORY_SCOPE_AGENT); }
__device__ __forceinline__ unsigned xch_add(unsigned* p, unsigned v) { return __hip_atomic_fetch_add(p, v, __ATOMIC_RELAXED, __HIP_MEMORY_SCOPE_AGENT); }
struct EpiOut {
    const float* x; const float* fg; float* out; unsigned char* ws;
    template <int RH> __device__ __forceinline__ void run(f32x4 (&acc)[2][2][4][2], const pg8::Unit& u, int wr, int wc, int fr, int fq) const {
        static_assert(RH < 0, "whole tiles only");
        const int pm = u.pm, pn = u.pn, b = pm >> 4;
        const float* const gate = (const float*)(ws + WS_GATE); float* const ssq = (float*)(ws + WS_SSQ); unsigned* const cnt = (unsigned*)(ws + WS_BAR) + PANEL_CNT_WORD;
        const int col0 = pn * 256 + 32 * wc + 8 * fq;
        {
            f32x4 gt[2][2];
#pragma unroll
            for (int bj = 0; bj < 2; ++bj)
#pragma unroll
                for (int n = 0; n < 2; ++n) gt[bj][n] = *(const f32x4*)(gate + b * DM + col0 + bj * 128 + 4 * n);
#pragma unroll
            for (int ai = 0; ai < 2; ++ai)
#pragma unroll
                for (int m = 0; m < 4; ++m) { const int row = pm * 256 + ai * 128 + wr * 64 + 16 * m + fr; float ss = 0.f;
#pragma unroll
                    for (int bj = 0; bj < 2; ++bj)
#pragma unroll
                        for (int n = 0; n < 2; ++n) { const f32x4 xv = *(const f32x4*)(x + (size_t)row * DM + col0 + bj * 128 + 4 * n); const f32x4 y = xv + gt[bj][n] * acc[ai][bj][m][n];
                            acc[ai][bj][m][n] = y; ss += (y[0] * y[0] + y[1] * y[1]) + (y[2] * y[2] + y[3] * y[3]); }
                    ss += __shfl_xor(ss, 16); ss += __shfl_xor(ss, 32);
                    if (fq == 0) __hip_atomic_store((unsigned*)ssq + (size_t)row * 32 + pn * 4 + wc, __float_as_uint(ss), __ATOMIC_RELAXED, __HIP_MEMORY_SCOPE_AGENT); }
        }
        asm volatile("s_waitcnt vmcnt(0)" ::: "memory");
        __syncthreads();
        if (wr == 0 && wc == 0 && fr == 0 && fq == 0) {
            unsigned* c = cnt + 64 * pm;
            (void)xch_add(c, 1u);
            unsigned sp = 0u; while (xch_ld(c) < 8u) { if (++sp > (1u << 22)) break; }
        }
        __syncthreads();
        f32x4 fgv[2][2];
#pragma unroll
        for (int bj = 0; bj < 2; ++bj)
#pragma unroll
            for (int n = 0; n < 2; ++n) fgv[bj][n] = *(const f32x4*)(fg + col0 + bj * 128 + 4 * n);
#pragma unroll
        for (int ai = 0; ai < 2; ++ai)
#pragma unroll
            for (int m = 0; m < 4; ++m) { const int row = pm * 256 + ai * 128 + wr * 64 + 16 * m + fr;
                const unsigned long long* p = (const unsigned long long*)(ssq + (size_t)row * 32 + 8 * fq);
                const unsigned long long q0 = __hip_atomic_load(p, __ATOMIC_RELAXED, __HIP_MEMORY_SCOPE_AGENT), q1 = __hip_atomic_load(p + 1, __ATOMIC_RELAXED, __HIP_MEMORY_SCOPE_AGENT),
                                         q2 = __hip_atomic_load(p + 2, __ATOMIC_RELAXED, __HIP_MEMORY_SCOPE_AGENT), q3 = __hip_atomic_load(p + 3, __ATOMIC_RELAXED, __HIP_MEMORY_SCOPE_AGENT);
#define LOF(q) __uint_as_float((unsigned)(q))
#define HIF(q) __uint_as_float((unsigned)((q) >> 32))
                float s = ((LOF(q0) + HIF(q0)) + (LOF(q1) + HIF(q1))) + ((LOF(q2) + HIF(q2)) + (LOF(q3) + HIF(q3)));
#undef LOF
#undef HIF
                s += __shfl_xor(s, 16); s += __shfl_xor(s, 32);
                const float rstd = rsqrtf(s * (1.f / DM) + EPS);
#pragma unroll
                for (int bj = 0; bj < 2; ++bj)
#pragma unroll
                    for (int n = 0; n < 2; ++n) __builtin_nontemporal_store(acc[ai][bj][m][n] * rstd * fgv[bj][n], (f32x4*)(out + (size_t)row * DM + col0 + bj * 128 + 4 * n)); }
    }
};

struct ConvFixHook {
    const bf16_t* Ub; const bf16_t* Gb; const float* convw; bf16_t* MIX; int e, tid;
    __device__ __forceinline__ void operator()() const {
        if (e >= 0 && tid < 128) { const int ch0 = tid * 8, m = (e >> 1) * 128 + ((e & 1) ? 127 : 0);
            const u32x4 z = {0u, 0u, 0u, 0u};
            const u32x4 up = ((m & (SEQ - 1)) == 0) ? z : *(const u32x4*)(Ub + (size_t)(m - 1) * CW + ch0);
            const u32x4 uc = *(const u32x4*)(Ub + (size_t)m * CW + ch0);
            const u32x4 un = ((m & (SEQ - 1)) == SEQ - 1) ? z : *(const u32x4*)(Ub + (size_t)(m + 1) * CW + ch0);
            const u32x4 gg = *(const u32x4*)(Gb + (size_t)m * CW + ch0);
            unsigned o[4];
#pragma unroll
            for (int q = 0; q < 4; ++q) {
                const float w0l = convw[ch0 + 2 * q], w0h = convw[ch0 + 2 * q + 1], w1l = convw[CW + ch0 + 2 * q], w1h = convw[CW + ch0 + 2 * q + 1], w2l = convw[2 * CW + ch0 + 2 * q], w2h = convw[2 * CW + ch0 + 2 * q + 1];
                const float lo = bflo(gg[q]) * (w0l * bflo(up[q]) + w1l * bflo(uc[q]) + w2l * bflo(un[q]));
                const float hi = bfhi(gg[q]) * (w0h * bfhi(up[q]) + w1h * bfhi(uc[q]) + w2h * bfhi(un[q]));
                o[q] = cvt_pk_bf16(lo, hi); }
            *(u32x4*)(MIX + (size_t)m * DM + AW + ch0) = (u32x4){o[0], o[1], o[2], o[3]}; }
    }
};

namespace att {
constexpr int D = 128, QBLK = 32, KVBLK = 64;
constexpr float SCALE = 0.088388347648318440f, QSCALE = SCALE * 1.4426950408889634f;
constexpr int LDQ = 1024, LDK = 256;
constexpr int NBUF = 3;
constexpr size_t SHM_V = KVBLK * D * 2, SHM_K = KVBLK * D * 2, SHM_ATTN = NBUF * (SHM_V + SHM_K) + NWAVES * 64 * 4;
constexpr int OST_PITCH = 272, OST_WAVE = 32 * OST_PITCH;
constexpr size_t WS_OFF = NBUF * (SHM_V + SHM_K);
static_assert(WS_OFF >= 8 * (size_t)OST_WAVE, "O staging below the l words");
#define KSWZ(row, colB) ((row) * 256 + ((colB) ^ (((row) & 7) << 4)))
#define SBAR() __builtin_amdgcn_sched_barrier(0)
__device__ __forceinline__ int crow(int r, int hi) { return (r & 3) + 8 * (r >> 2) + 4 * hi; }
__device__ __forceinline__ void expHalf(f32x16& p) {
#pragma unroll
  for (int r = 0; r < 16; ++r) p[r] = __builtin_amdgcn_exp2f(p[r]);
}
__device__ __forceinline__ void finishSM(f32x16& p0, f32x16& p1, float& l_reg, bf16x8& pa0, bf16x8& pa1, bf16x8& pa2, bf16x8& pa3) {
  expHalf(p1);
  float ps = 0;
#pragma unroll
  for (int r = 0; r < 16; ++r) ps += p0[r];
#pragma unroll
  for (int r = 0; r < 16; ++r) ps += p1[r];
  { auto rr = __builtin_amdgcn_permlane32_swap(__float_as_uint(ps), __float_as_uint(ps), false, false);
    ps = __uint_as_float(rr[0]) + __uint_as_float(rr[1]); }
  l_reg += ps;
#define PK4(P, BASE, OUT) do { unsigned a0 = cvt_pk_bf16(P[BASE + 0], P[BASE + 1]), a1 = cvt_pk_bf16(P[BASE + 2], P[BASE + 3]);   \
    unsigned b0 = cvt_pk_bf16(P[BASE + 4], P[BASE + 5]), b1 = cvt_pk_bf16(P[BASE + 6], P[BASE + 7]);                              \
    auto r0 = __builtin_amdgcn_permlane32_swap(a0, b0, false, false); auto r1 = __builtin_amdgcn_permlane32_swap(a1, b1, false, false); \
    u32x4 w = {r0[0], r1[0], r0[1], r1[1]}; OUT = *reinterpret_cast<bf16x8*>(&w); } while (0)
  PK4(p0, 0, pa0); PK4(p0, 8, pa1); PK4(p1, 0, pa2); PK4(p1, 8, pa3);
#undef PK4
}
__device__ __forceinline__ void qkt(f32x16& p0, f32x16& p1, const char* Ks, const bf16x8* qr, int r32, int hi, float init) {
#pragma unroll
  for (int r = 0; r < 16; ++r) { p0[r] = init; p1[r] = init; }
#define KLD(d0, half) (*reinterpret_cast<const bf16x8*>(Ks + KSWZ((half) * 32 + r32, ((d0) * 16 + hi * 8) * 2)))
  bf16x8 a0 = KLD(0, 0), a1 = KLD(0, 1);
  __builtin_amdgcn_s_setprio(1);
#pragma unroll
  for (int d0 = 0; d0 < 8; ++d0) {
    bf16x8 n0 = a0, n1 = a1;
    if (d0 < 7) { n0 = KLD(d0 + 1, 0); n1 = KLD(d0 + 1, 1); }
    p0 = __builtin_amdgcn_mfma_f32_32x32x16_bf16(a0, qr[d0], p0, 0, 0, 0);
    p1 = __builtin_amdgcn_mfma_f32_32x32x16_bf16(a1, qr[d0], p1, 0, 0, 0);
    a0 = n0; a1 = n1; }
  __builtin_amdgcn_s_setprio(0);
#undef KLD
}
__device__ __forceinline__ int v_st(int k, int c) { const int kk = (k & ~0xC) | ((k & 4) << 1) | ((k & 8) >> 1); return ((kk >> 3) * 4 + (c >> 5)) * 512 + ((kk & 7) * 32 + (c & 31)) * 2; }
__device__ __forceinline__ int v_rd_base(int lane) { return ((lane & 3) << 3) | (((lane >> 2) & 3) << 6) | (((lane >> 4) & 1) << 5) | (((lane >> 5) & 1) << 8); }
constexpr int v_rd_off(int d0, int ks, int half) { return d0 * 512 + ks * 4096 + half * 2048; }
template <int OFF> __device__ __forceinline__ s16x4 tr_read(int vb) {
  s16x4 r; asm volatile("ds_read_b64_tr_b16 %0, %1 offset:%2" : "=&v"(r) : "v"(vb), "i"(OFF) : "memory"); return r;
}
struct VFrag { s16x4 l0, h0, l1, h1, l2, h2, l3, h3; };
template <int D0> __device__ __forceinline__ void pv_rd(VFrag& f, int vb) {
  f.l0 = tr_read<v_rd_off(D0, 0, 0)>(vb); f.h0 = tr_read<v_rd_off(D0, 0, 1)>(vb); f.l1 = tr_read<v_rd_off(D0, 1, 0)>(vb); f.h1 = tr_read<v_rd_off(D0, 1, 1)>(vb);
  f.l2 = tr_read<v_rd_off(D0, 2, 0)>(vb); f.h2 = tr_read<v_rd_off(D0, 2, 1)>(vb); f.l3 = tr_read<v_rd_off(D0, 3, 0)>(vb); f.h3 = tr_read<v_rd_off(D0, 3, 1)>(vb);
}
__device__ __forceinline__ void pv_mm(f32x16& od, const VFrag& f, bf16x8 pa0, bf16x8 pa1, bf16x8 pa2, bf16x8 pa3) {
#define PK(L, H) (bf16x8){L[0], L[1], L[2], L[3], H[0], H[1], H[2], H[3]}
  __builtin_amdgcn_s_setprio(1);
  od = __builtin_amdgcn_mfma_f32_32x32x16_bf16(pa0, PK(f.l0, f.h0), od, 0, 0, 0);
  od = __builtin_amdgcn_mfma_f32_32x32x16_bf16(pa1, PK(f.l1, f.h1), od, 0, 0, 0);
  od = __builtin_amdgcn_mfma_f32_32x32x16_bf16(pa2, PK(f.l2, f.h2), od, 0, 0, 0);
  od = __builtin_amdgcn_mfma_f32_32x32x16_bf16(pa3, PK(f.l3, f.h3), od, 0, 0, 0);
  __builtin_amdgcn_s_setprio(0);
#undef PK
}
__device__ __forceinline__ void pv_d0(f32x16* o, int vb, bf16x8 pa0, bf16x8 pa1, bf16x8 pa2, bf16x8 pa3) {
  VFrag fa, fb;
  pv_rd<0>(fa, vb); pv_rd<1>(fb, vb);
  asm volatile("s_waitcnt lgkmcnt(8)" ::: "memory"); SBAR(); pv_mm(o[0], fa, pa0, pa1, pa2, pa3); SBAR();
  pv_rd<2>(fa, vb);
  asm volatile("s_waitcnt lgkmcnt(8)" ::: "memory"); SBAR(); pv_mm(o[1], fb, pa0, pa1, pa2, pa3); SBAR();
  pv_rd<3>(fb, vb);
  asm volatile("s_waitcnt lgkmcnt(8)" ::: "memory"); SBAR(); pv_mm(o[2], fa, pa0, pa1, pa2, pa3); SBAR();
  asm volatile("s_waitcnt lgkmcnt(0)" ::: "memory"); SBAR(); pv_mm(o[3], fb, pa0, pa1, pa2, pa3);
}
template <class Hook>
__device__ __forceinline__ void attn_dense_body(const bf16_t* __restrict__ Qb, const bf16_t* __restrict__ Kh, const bf16_t* __restrict__ Vh,
                                                const bf16_t* __restrict__ GAb, bf16_t* __restrict__ MIXb, const float* __restrict__ qg, const float* __restrict__ kg, int seq, char* lds, int wave_s, const Hook& hook) {
  const int tid = opaque_tid(wave_s), wid = wave_s, lane = tid & 63, r32 = lane & 31, hi = lane >> 5;
  char* V_lds = lds; char* K_lds = lds + NBUF * SHM_V;
#define TO_LAS(p) ((LAS unsigned char*)(unsigned)(uintptr_t)(p))
  float* ws = (float*)(lds + WS_OFF) + wid * 64; float* li_l = ws;
  float l_reg = 0; f32x16 o[4] = {}; bf16x8 qr[8];
  float init;
  { float gq = fmaxf(fabsf(qg[lane]), fabsf(qg[lane + 64])), gk = fmaxf(fabsf(kg[lane]), fabsf(kg[lane + 64]));
#pragma unroll
    for (int ofs = 1; ofs < 64; ofs <<= 1) { gq = fmaxf(gq, __shfl_xor(gq, ofs)); gk = fmaxf(gk, __shfl_xor(gk, ofs)); }
    init = -(QSCALE * 128.f * 1.02f) * gq * gk; }
  const bf16_t* Qw = Qb + (long)(wid * QBLK + r32) * LDQ + hi * 8;
#pragma unroll
  for (int d0 = 0; d0 < 8; ++d0) qr[d0] = *reinterpret_cast<const bf16x8*>(Qw + d0 * 16);
  const int vb0 = (int)(uintptr_t)V_lds + v_rd_base(lane);
  int koff[2], voff[2];
#pragma unroll
  for (int i = 0; i < 2; ++i) { const int p = (i * 8 + wid) * 64 + lane;
    { const int row = p >> 4, c = (p & 15) ^ (row & 7); koff[i] = row * LDK + c * 8; }
    { const int S = p >> 5, within = p & 31, kk = (S >> 2) * 8 + (within >> 2), k = (kk & ~0xC) | ((kk & 4) << 1) | ((kk & 8) >> 1), col = (S & 3) * 32 + (within & 3) * 8;
      voff[i] = k * LDK + col; } }
#define DMA_TILE(b, k0) do { _Pragma("unroll") for (int _i = 0; _i < 2; ++_i) { \
    __builtin_amdgcn_global_load_lds((const unsigned*)(Kh + (long)(k0) * LDK + koff[_i]), (LAS unsigned*)(TO_LAS(K_lds) + (b) * (int)SHM_K + (_i * 8 + wid) * 1024), 16, 0, 0); \
    __builtin_amdgcn_global_load_lds((const unsigned*)(Vh + (long)(k0) * LDK + voff[_i]), (LAS unsigned*)(TO_LAS(V_lds) + (b) * (int)SHM_V + (_i * 8 + wid) * 1024), 16, 0, 0); } } while (0)
  f32x16 pA0, pA1, pB0, pB1; bf16x8 pa0, pa1, pa2, pa3; const int NT = seq / KVBLK;
  int bc = 0, bn = 1, bw = 2;
  DMA_TILE(0, 0); DMA_TILE(1, KVBLK);
  hook();
  __syncthreads();
  qkt(pA0, pA1, K_lds, qr, r32, hi, init); expHalf(pA0);
#define ROT() do { const int _t = bc; bc = bn; bn = bw; bw = _t; } while (0)
#define ITER(PC0, PC1, PN0, PN1, t) do { __syncthreads(); \
    if ((t) + 2 < NT) DMA_TILE(bw, ((t) + 2) * KVBLK); \
    SBAR(); qkt(PN0, PN1, K_lds + bn * (int)SHM_K, qr, r32, hi, init); finishSM(PC0, PC1, l_reg, pa0, pa1, pa2, pa3); SBAR(); \
    pv_d0(o, vb0 + bc * (int)SHM_V, pa0, pa1, pa2, pa3); expHalf(PN0); ROT(); } while (0)
  for (int t = 0; t + 2 < NT; t += 2) { ITER(pA0, pA1, pB0, pB1, t); ITER(pB0, pB1, pA0, pA1, t + 1); }
  ITER(pA0, pA1, pB0, pB1, NT - 2);
  finishSM(pB0, pB1, l_reg, pa0, pa1, pa2, pa3); SBAR();
  pv_d0(o, vb0 + bc * (int)SHM_V, pa0, pa1, pa2, pa3);
#undef ITER
#undef ROT
#undef DMA_TILE
  if (hi == 0) li_l[r32] = l_reg; asm volatile("s_waitcnt lgkmcnt(0)" ::: "memory");
  __syncthreads();
  { char* ost = lds + wid * OST_WAVE;
#pragma unroll
    for (int r = 0; r < 16; ++r) { const int orow = crow(r, hi); const float rl = __builtin_amdgcn_rcpf(li_l[orow]);
#pragma unroll
      for (int d0 = 0; d0 < 4; ++d0) *(bf16_t*)(ost + orow * OST_PITCH + (d0 * 32 + r32) * 2) = (bf16_t)(cvt_pk_bf16(o[d0][r] * rl, 0.f) & 0xffffu); }
    asm volatile("s_waitcnt lgkmcnt(0)" ::: "memory");
#pragma unroll
    for (int i = 0; i < 8; ++i) { const int id = i * 64 + lane, row = id >> 4, cc = id & 15; const long grow = wid * QBLK + row;
      const u32x4 ov = *(const u32x4*)(ost + row * OST_PITCH + cc * 16); const u32x4 gv = *(const u32x4*)(GAb + grow * 1024 + cc * 8);
      u32x4 w;
#pragma unroll
      for (int q = 0; q < 4; ++q) w[q] = cvt_pk_bf16(bflo(ov[q]) * bflo(gv[q]), bfhi(ov[q]) * bfhi(gv[q]));
      *(u32x4*)(MIXb + grow * 2048 + cc * 8) = w; }
  }
  __syncthreads();
}
#undef KSWZ
#undef SBAR
}

__device__ __forceinline__ void p0_adaln(const float* __restrict__ c, const float* __restrict__ cctx, const float* __restrict__ wmod, float* part, LAS float* red,
                                         int tid, int wave, int lane, int bid, int G) {
    for (int it = bid; it < 192; it += G) {
        const int sl = it % 24, kc = it / 24, col = sl * 256 + 4 * lane, k0 = kc * 256 + wave * 32;
        f32x4 wv[32];
#pragma unroll
        for (int i = 0; i < 32; ++i) wv[i] = __builtin_nontemporal_load((const f32x4*)(wmod + (size_t)(k0 + i) * 6144 + col));
        f32x4 a0 = {0.f, 0.f, 0.f, 0.f}, a1 = a0, a2 = a0;
#pragma unroll
        for (int i = 0; i < 32; ++i) { const int k = k0 + i; a0 += silu_acc(c[k]) * wv[i]; a1 += silu_acc(c[DM + k]) * wv[i]; a2 += silu_acc(cctx[k]) * wv[i]; }
        *(LAS f32x4*)(red + ((wave * 3 + 0) * 64 + lane) * 4) = a0; *(LAS f32x4*)(red + ((wave * 3 + 1) * 64 + lane) * 4) = a1; *(LAS f32x4*)(red + ((wave * 3 + 2) * 64 + lane) * 4) = a2;
        __syncthreads();
        if (tid < 192) { const int r = tid >> 6, l = tid & 63; f32x4 sm = {0.f, 0.f, 0.f, 0.f};
#pragma unroll
            for (int w = 0; w < 8; ++w) sm += *(const LAS f32x4*)(red + ((w * 3 + r) * 64 + l) * 4);
            *(f32x4*)(part + ((size_t)kc * 3 + r) * 6144 + sl * 256 + 4 * l) = sm; }
        __syncthreads();
    }
}
template <bool PERMUTE>
__device__ __forceinline__ void p0_transpose_item(const float* __restrict__ W, int K, int N, bf16_t* WT, LAS float* scr, int item, int lane) {
    const int nblk = N / 32, kb = item / nblk, nb = item % nblk, k0 = 64 * kb, n0 = 32 * nb;
    const int srcc = PERMUTE ? win_src_col(n0 + (lane & 31)) : n0 + (lane & 31);
    float tv[32];
#pragma unroll
    for (int i = 0; i < 32; ++i) tv[i] = __builtin_nontemporal_load(W + (size_t)(k0 + 2 * i + (lane >> 5)) * N + srcc);
#pragma unroll
    for (int i = 0; i < 32; ++i) scr[(2 * i + (lane >> 5)) * 33 + (lane & 31)] = tv[i];
    LDS_WAIT(); asm volatile("" ::: "memory");
    const int cch = lane & 7;
#pragma unroll
    for (int j = 0; j < 4; ++j) { const int n = (lane >> 3) + 8 * j; const LAS float* s = scr + (8 * cch) * 33 + n;
        u32x4 o; o.x = cvt_pk_bf16(s[0 * 33], s[1 * 33]); o.y = cvt_pk_bf16(s[2 * 33], s[3 * 33]); o.z = cvt_pk_bf16(s[4 * 33], s[5 * 33]); o.w = cvt_pk_bf16(s[6 * 33], s[7 * 33]);
        *(u32x4*)(WT + (size_t)(n0 + n) * K + k0 + 8 * cch) = o; }
    LDS_WAIT(); asm volatile("" ::: "memory");
}
template <int MODE> __host__ __device__ __forceinline__ void tt_map(int T, int j, int& src, int& dst) {
    if (MODE == 1 || (T >= 5 && T <= 9)) { src = T * 256 + j; dst = j; return; }
    if (T <= 4) { src = T * 256 + j; const int hh = j >> 7, d = j & 127; const int sl = d < 32 ? 2 * d : d < 64 ? 2 * (d - 32) + 1 : d < 96 ? 2 * (d - 32) : 2 * (d - 64) + 1; dst = hh * 128 + sl; return; }
    const int ct = T - 10, r = j >> 6, c = j & 63; const int sec = r == 0 ? 3584 : r == 1 ? 4608 : r == 2 ? 2560 : 5632; src = sec + 64 * ct + c; dst = (r >> 1) * 128 + 2 * c + (r & 1);
}
constexpr int TT_PITCH = 144;
constexpr int TT_TILE_BYTES = 256 * TT_PITCH;
template <int MODE> __device__ __forceinline__ void tt_load(const float* __restrict__ W, int N, int kb, int T, int wave, int lane, f32x4 (&v)[8]) {
    int src, dst; tt_map<MODE>(T, 4 * lane, src, dst); (void)dst;
#pragma unroll
    for (int i = 0; i < 8; ++i) v[i] = __builtin_nontemporal_load((const f32x4*)(W + (size_t)(kb * 64 + wave * 8 + i) * N + src));
}
template <int MODE> __device__ __forceinline__ void tt_to_lds(LAS unsigned char* tile, int T, int wave, int lane, const f32x4 (&v)[8]) {
#pragma unroll
    for (int c = 0; c < 4; ++c) { int src, dst; tt_map<MODE>(T, 4 * lane + c, src, dst); (void)src;
        *(LAS u32x4*)(tile + dst * TT_PITCH + 16 * wave) = (u32x4){cvt_pk_bf16(v[0][c], v[1][c]), cvt_pk_bf16(v[2][c], v[3][c]), cvt_pk_bf16(v[4][c], v[5][c]), cvt_pk_bf16(v[6][c], v[7][c])}; }
}
__device__ __forceinline__ void tt_store(const LAS unsigned char* tile, bf16_t* WT, int K, int kb, int T, int tid) {
#pragma unroll
    for (int q = 0; q < 4; ++q) { const int id = q * NTHREADS + tid, n = id >> 3, cc = id & 7;
        *(u32x4*)(WT + (size_t)(T * 256 + n) * K + kb * 64 + 8 * cc) = *(const LAS u32x4*)(tile + n * TT_PITCH + 16 * cc); }
}
template <int MODE> __device__ __forceinline__ void tt_run(const float* __restrict__ W, int K, int N, bf16_t* WT, int NT, unsigned* queue, int first, int stride,
                                                          LAS unsigned char* tile, volatile LAS unsigned* word, int tid, int wave, int lane) {
    const int ntiles = (K / 64) * NT;
    if (tid == 0) *word = queue ? atomicAdd(queue, 1u) : (unsigned)first;
    __syncthreads();
    int it = (int)*word, nstat = first;
    f32x4 v[8];
    if (it < ntiles) tt_load<MODE>(W, N, it / NT, it % NT, wave, lane, v);
    __syncthreads();
    while (it < ntiles) {
        const int kb = it / NT, T = it % NT;
        tt_to_lds<MODE>(tile, T, wave, lane, v);
        nstat += stride;
        if (tid == 0) *word = queue ? atomicAdd(queue, 1u) : (unsigned)nstat;
        __syncthreads();
        const int nx = (int)*word;
        if (nx < ntiles) tt_load<MODE>(W, N, nx / NT, nx % NT, wave, lane, v);
        tt_store(tile, WT, K, kb, T, tid);
        __syncthreads();
        it = nx;
    }
}

template <int NR>
__device__ __forceinline__ void h_rows(const float* __restrict__ x0, bf16_t* o0, const LAS float* AL, const LAS float* SL, int lane) {
    f32x4 v[NR][8]; float rstd[NR];
#pragma unroll
    for (int r = 0; r < NR; ++r)
#pragma unroll
        for (int j = 0; j < 8; ++j) v[r][j] = ((const f32x4*)(x0 + (size_t)r * DM))[lane + 64 * j];
#pragma unroll
    for (int r = 0; r < NR; ++r) { float s = 0.f;
#pragma unroll
        for (int j = 0; j < 8; ++j) s += (v[r][j][0] * v[r][j][0] + v[r][j][1] * v[r][j][1]) + (v[r][j][2] * v[r][j][2] + v[r][j][3] * v[r][j][3]);
        rstd[r] = rsqrtf(wave_sum(s) * (1.f / DM) + EPS); }
#pragma unroll
    for (int j = 0; j < 8; ++j) { const f32x4 a = *(const LAS f32x4*)(AL + 4 * lane + 256 * j), sh = *(const LAS f32x4*)(SL + 4 * lane + 256 * j);
#pragma unroll
        for (int r = 0; r < NR; ++r) { const f32x4 h = v[r][j] * rstd[r] * a + sh;
            *(u32x2*)(o0 + (size_t)r * DM + 4 * lane + 256 * j) = (u32x2){cvt_pk_bf16(h[0], h[1]), cvt_pk_bf16(h[2], h[3])}; } }
}

#define XB_TMO      128
#define XB_XCNT(j)  (256  + 64 * (j))
#define XB_XSUB(j)  (1280 + 64 * (j))
#define XB_XGEN(j)  (2304 + 64 * (j))
#define XB_TOP      3328
#define XB_TOPGEN   3392
#define XCD_BAR_WORDS 3456
#define XB_SPIN_CAP (1u << 22)
__device__ __forceinline__ unsigned xb_ld(unsigned* p)              { return __hip_atomic_load(p, __ATOMIC_RELAXED, __HIP_MEMORY_SCOPE_AGENT); }
__device__ __forceinline__ unsigned xb_add(unsigned* p, unsigned v) { return __hip_atomic_fetch_add(p, v, __ATOMIC_RELAXED, __HIP_MEMORY_SCOPE_AGENT); }
__device__ __forceinline__ unsigned xb_xcc_id() { return (unsigned)__builtin_amdgcn_s_getreg((3 << 11) | 20) & 0xFu; }
#define XB_SPIN(cond, bar) do { unsigned _sp = 0; while (cond) {   \
    if ((++_sp & 255u) == 0u) { if (xb_ld(&(bar)[XB_TMO])) break; if (_sp > XB_SPIN_CAP) { atomicAdd(&(bar)[XB_TMO], 1u); break; } } } } while (0)
struct XcdBarrier { unsigned* bar; unsigned x; volatile LAS unsigned* st; };
__device__ __forceinline__ XcdBarrier xcd_barrier_post(unsigned* bar, volatile LAS unsigned* st, bool leader) {
    XcdBarrier b; b.bar = bar; b.x = xb_xcc_id(); b.st = st;
    if (leader) (void)xb_add(&bar[XB_XCNT(b.x)], 1u);
    return b;
}
__device__ __forceinline__ void xcd_barrier_complete(unsigned* bar, unsigned x, unsigned& nloc, unsigned& nx) {
    const unsigned G = gridDim.x * gridDim.y * gridDim.z;
    unsigned sum, cnt, mine, sp = 0u;
    for (;;) {
        sum = 0u; cnt = 0u; mine = 0u;
#pragma unroll
        for (unsigned j = 0; j < 16; ++j) { const unsigned c = xb_ld(&bar[XB_XCNT(j)]); sum += c; cnt += (c > 0u) ? 1u : 0u; mine = (j == x) ? c : mine; }
        if (sum == G) break;
        __builtin_amdgcn_s_sleep(1);
        if ((++sp & 255u) == 0u) { if (xb_ld(&bar[XB_TMO])) break; if (sp > XB_SPIN_CAP) { atomicAdd(&bar[XB_TMO], 1u); break; } }
    }
    nloc = mine > 0u ? mine : 1u; nx = cnt > 0u ? cnt : 1u;
}
__device__ __forceinline__ void xcd_barrier(const XcdBarrier& b, bool leader) {
    asm volatile("s_waitcnt vmcnt(0)" ::: "memory");
    __syncthreads();
    if (leader) {
        unsigned* bar = b.bar;
        __builtin_amdgcn_s_waitcnt(0);
        unsigned nloc = b.st[0], nx = b.st[1];
        if (nloc == 0u) { xcd_barrier_complete(bar, b.x, nloc, nx); b.st[0] = nloc; b.st[1] = nx; }
        const unsigned old = xb_add(&bar[XB_XSUB(b.x)], 1u);
        const unsigned gen = old / nloc;
        if (old + 1u == (gen + 1u) * nloc) {
            __builtin_amdgcn_fence(__ATOMIC_RELEASE, "agent");
            asm volatile("s_waitcnt vmcnt(0)" ::: "memory");
            const unsigned og = xb_add(&bar[XB_TOP], 1u);
            const unsigned tg = og / nx;
            if (og + 1u == (tg + 1u) * nx) xb_add(&bar[XB_TOPGEN], 1u);
            else XB_SPIN(xb_ld(&bar[XB_TOPGEN]) == tg, bar);
            __builtin_amdgcn_fence(__ATOMIC_ACQUIRE, "agent");
            xb_add(&bar[XB_XGEN(b.x)], 1u);
            asm volatile("s_waitcnt vmcnt(0)" ::: "memory");
        } else {
            XB_SPIN(xb_ld(&bar[XB_XGEN(b.x)]) == gen, bar);
            __builtin_amdgcn_fence(__ATOMIC_ACQUIRE, "agent");
            asm volatile("s_waitcnt vmcnt(0)" ::: "memory");
        }
    }
    __syncthreads();
}

struct Args {
    const float *x, *c, *ctx, *cctx, *wmod, *bmod, *normg, *win, *qg, *kg, *convw, *wout, *fg;
    float* out; unsigned char* ws;
    int use_cg, pad;
};

__global__ void __launch_bounds__(NTHREADS, 2) fwd_megakernel(Args a) {
    extern __shared__ __attribute__((aligned(16))) unsigned char lds_raw[];
    cg::grid_group grid = cg::this_grid();
    LAS unsigned char* lds = (LAS unsigned char*)lds_raw;
    const int bid = blockIdx.x, G = gridDim.x;
    const int wave_s = __builtin_amdgcn_readfirstlane(threadIdx.x >> 6);
    const bool leader = (threadIdx.x == 0);
    volatile LAS unsigned* MISC = (volatile LAS unsigned*)(lds + MISC_OFF);
    if (threadIdx.x < 4) MISC[threadIdx.x] = 0u;
    __syncthreads();
    const XcdBarrier xbar = xcd_barrier_post((unsigned*)(a.ws + WS_BAR), MISC, leader);
#define GRID_SEAM() do { if (a.use_cg) grid.sync(); else xcd_barrier(xbar, threadIdx.x == 0); } while (0)
#define PHASE_IDS() const int tid = opaque_tid(wave_s), lane = tid & 63, wave = wave_s; (void)lane; (void)wave
    unsigned char* ws = a.ws;
    float* PART = (float*)(ws + WS_PART); float* GATE = (float*)(ws + WS_GATE); float* SSQ = (float*)(ws + WS_SSQ);
    bf16_t* WIN = (bf16_t*)(ws + WS_WIN); bf16_t* WOUT = (bf16_t*)(ws + WS_WOUT); bf16_t* H = (bf16_t*)(ws + WS_H);
    bf16_t* Qb = (bf16_t*)(ws + WS_Q); bf16_t* KB = (bf16_t*)(ws + WS_K); bf16_t* VB = (bf16_t*)(ws + WS_V);
    bf16_t* GA = (bf16_t*)(ws + WS_GA); bf16_t* Ub = (bf16_t*)(ws + WS_U); bf16_t* Gb = (bf16_t*)(ws + WS_G); bf16_t* MIX = (bf16_t*)(ws + WS_MIX);

    {
        PHASE_IDS();
        p0_adaln(a.c, a.cctx, a.wmod, PART, (LAS float*)lds, tid, wave, lane, bid, G);
        tt_run<0>(a.win, DM, NIN, WIN, NIN / 256, (unsigned*)(ws + WS_BAR) + TT_QUEUE_WORD, 0, 0, lds + 32768, (volatile LAS unsigned*)(lds + XCH_OFF), tid, wave, lane);
    }
    GRID_SEAM();

    {
        PHASE_IDS();
        LAS float* AL0 = (LAS float*)lds; LAS float* SL0 = AL0 + DM; LAS float* AL2 = SL0 + DM; LAS float* SL2 = AL2 + DM;
        for (int idx = bid * NTHREADS + tid; idx < NB * DM; idx += G * NTHREADS) { const int r = idx >> 11, n = (idx & (DM - 1)) + 2 * DM; float s = a.bmod[n];
#pragma unroll
            for (int kc = 0; kc < 8; ++kc) s += PART[((size_t)kc * 3 + r) * 6144 + n];
            GATE[idx] = s; }
        for (int ch = bid; ch < MLAT / 32; ch += G) {
            const int r = ch >> 7;
            __syncthreads();
            { const int n4 = 4 * tid;
                f32x4 sh0 = *(const f32x4*)(a.bmod + n4), sc0 = *(const f32x4*)(a.bmod + DM + n4), sh2 = sh0, sc2 = sc0;
#pragma unroll
                for (int kc = 0; kc < 8; ++kc) { const float* p = PART + (size_t)kc * 3 * 6144;
                    sh0 += *(const f32x4*)(p + r * 6144 + n4); sc0 += *(const f32x4*)(p + r * 6144 + DM + n4); sh2 += *(const f32x4*)(p + 2 * 6144 + n4); sc2 += *(const f32x4*)(p + 2 * 6144 + DM + n4); }
                const f32x4 gn = *(const f32x4*)(a.normg + n4);
                *(LAS f32x4*)(AL0 + n4) = gn * (1.f + sc0); *(LAS f32x4*)(SL0 + n4) = sh0; *(LAS f32x4*)(AL2 + n4) = gn * (1.f + sc2); *(LAS f32x4*)(SL2 + n4) = sh2;
            }
            __syncthreads();
            { const int m = ch * 32 + wave * 4; h_rows<4>(a.x + (size_t)m * DM, H + (size_t)m * DM, AL0, SL0, lane); }
            if (wave < 2) { const int mc = ch * 2 + wave; if (mc < MCTX) h_rows<1>(a.ctx + (size_t)mc * DM, H + (size_t)(MLAT + mc) * DM, AL2, SL2, lane); }
        }
        __syncthreads();
    }
    GRID_SEAM();

    {
        typedef pg8::TileMap<MLAT / 256, NIN / 256, 4, 32, 4, 2> MapIn;
        const int Rfull = MapIn::ntot / G, tail = MapIn::ntot - Rfull * G; const bool split = (2 * tail <= G);
        pg8::Gemm g{H, WIN, MALL, NIN, DM};
        EpiIn E{ws, a.qg, a.kg, a.convw, (LAS float*)(lds + XCH_OFF)};
        const bool has_tail = split && bid < 2 * tail;
        pg8::Unit tu; tu.pm = 0; tu.pn = 0; if (has_tail) MapIn::decode(Rfull * G + (bid >> 1), tu);
        { pg8::StaticOrder<MapIn> S; S.init(G, bid, split ? Rfull * G : MapIn::ntot);
          if (has_tail) pg8::gemm_phase<EpiIn, pg8::StaticOrder<MapIn>, -1, true, false>(lds, g, S, E, wave_s, &tu);
          else          pg8::gemm_phase<EpiIn, pg8::StaticOrder<MapIn>, -1>(lds, g, S, E, wave_s); }
        if (has_tail) { pg8::OneUnit<MapIn> S1{Rfull * G + (bid >> 1)};
            if (bid & 1) pg8::gemm_phase<EpiIn, pg8::OneUnit<MapIn>, 1, false, true>(lds, g, S1, E, wave_s);
            else         pg8::gemm_phase<EpiIn, pg8::OneUnit<MapIn>, 0, false, true>(lds, g, S1, E, wave_s); }
        { PHASE_IDS();
          const int first_idle = (2 * tail <= G) ? 2 * tail : tail, n_idle = first_idle == 0 ? G : G - first_idle, me = first_idle == 0 ? bid : bid - first_idle;
          if (me >= 0) tt_run<1>(a.wout, DM, DM, WOUT, DM / 256, nullptr, me, n_idle, lds + 32768, (volatile LAS unsigned*)(lds + XCH_OFF), tid, wave, lane); }
    }
    GRID_SEAM();

    {
        PHASE_IDS();
        if (bid < 256) {
            const int ui = bid;
            const int xq = ui & 7, idx = (ui >> 3) + 32 * (xq & 1), combo = xq >> 1, b = combo >> 1, kvh = combo & 1, h = kvh * 4 + (idx >> 4), qb = idx & 15;
            const size_t row0 = (size_t)b * SEQ + qb * 256;
            att::attn_dense_body(Qb + row0 * AW + h * HD, KB + (size_t)b * SKV * 256 + kvh * HD, VB + (size_t)b * SKV * 256 + kvh * HD,
                                 GA + row0 * AW + h * HD, MIX + row0 * DM + h * HD, a.qg, a.kg, SKV, (char*)lds_raw, wave_s,
                                 ConvFixHook{Ub, Gb, a.convw, MIX, bid < MLAT / 64 ? bid : -1, tid});
        }
    }
    GRID_SEAM();

    {
        typedef pg8::TileMap<MLAT / 256, DM / 256> MapOut;
        pg8::Gemm g{MIX, WOUT, MLAT, DM, DM}; pg8::OneUnit<MapOut> S{bid < MapOut::ntot ? bid : -1};
        EpiOut E{a.x, a.fg, a.out, ws};
        pg8::gemm_phase<EpiOut, pg8::OneUnit<MapOut>, -1>(lds, g, S, E, wave_s);
    }
}

extern "C" void kernel_launch(void* const* d_in, const int* in_sizes, int n_in, void* d_out, int out_size, void* d_ws, size_t ws_size, hipStream_t stream) {
    static int grid_blocks = 0;
    if (grid_blocks == 0) {
        if (n_in != 13 || in_sizes[0] != MLAT * DM || out_size != MLAT * DM || ws_size < WS_END) { fprintf(stderr, "kernel_launch: shape mismatch (n_in %d in0 %d out %d ws %zu)\n", n_in, n_in > 0 ? in_sizes[0] : -1, out_size, ws_size); grid_blocks = -1; return; }
        int dev = 0, cus = 0, per_cu = 0;
        hipGetDevice(&dev);
        hipDeviceGetAttribute(&cus, hipDeviceAttributeMultiprocessorCount, dev);
        if (hipFuncSetAttribute((const void*)fwd_megakernel, hipFuncAttributeMaxDynamicSharedMemorySize, LDS_BYTES) != hipSuccess) { fprintf(stderr, "kernel_launch: hipFuncSetAttribute failed\n"); grid_blocks = -1; return; }
        if (hipOccupancyMaxActiveBlocksPerMultiprocessor(&per_cu, (const void*)fwd_megakernel, NTHREADS, LDS_BYTES) != hipSuccess || per_cu < 1) { fprintf(stderr, "kernel_launch: occupancy query gave %d\n", per_cu); per_cu = 1; }
        (void)hipGetLastError();
        grid_blocks = cus * per_cu;
        if (grid_blocks > 256) grid_blocks = 256;
    }
    if (grid_blocks < 0) return;
    Args a{};
    a.x = (const float*)d_in[0]; a.c = (const float*)d_in[1]; a.ctx = (const float*)d_in[2]; a.cctx = (const float*)d_in[3];
    a.wmod = (const float*)d_in[4]; a.bmod = (const float*)d_in[5]; a.normg = (const float*)d_in[6]; a.win = (const float*)d_in[7];
    a.qg = (const float*)d_in[8]; a.kg = (const float*)d_in[9]; a.convw = (const float*)d_in[10]; a.wout = (const float*)d_in[11]; a.fg = (const float*)d_in[12];
    a.out = (float*)d_out; a.ws = (unsigned char*)d_ws; a.use_cg = 0; a.pad = 0;
    if (hipMemsetAsync((char*)d_ws + WS_BAR, 0, CTL_BYTES, stream) != hipSuccess) { fprintf(stderr, "kernel_launch: hipMemsetAsync failed\n"); return; }
    void* args[] = {&a};
    hipError_t e = hipLaunchCooperativeKernel((const void*)fwd_megakernel, dim3(grid_blocks), dim3(NTHREADS), args, LDS_BYTES, stream);
    if (e != hipSuccess) fprintf(stderr, "cooperative launch failed: %s (grid %d)\n", hipGetErrorString(e), grid_blocks);
}
```

```cpp
#include <hip/hip_runtime.h>
#include <hip/hip_cooperative_groups.h>
#include <cstdio>
#include <cstdint>
namespace cg = cooperative_groups;

#define LAS __attribute__((address_space(3)))
typedef unsigned short bf16_t;
typedef short bf16x8 __attribute__((ext_vector_type(8)));
typedef short s16x4 __attribute__((ext_vector_type(4)));
typedef float f32x2 __attribute__((ext_vector_type(2)));
typedef float f32x4 __attribute__((ext_vector_type(4)));
typedef float f32x16 __attribute__((ext_vector_type(16)));
typedef unsigned u32x2 __attribute__((ext_vector_type(2)));
typedef unsigned u32x4 __attribute__((ext_vector_type(4)));

constexpr int DM = 2048, NB = 2, SEQ = 4096, CTX = 256, MLAT = NB * SEQ, MCTX = NB * CTX, MALL = MLAT + MCTX;
constexpr int NIN = 6656, HD = 128, NH = 8, NKV = 2, SKV = CTX + SEQ, AW = 1024, CW = 1024;
constexpr float EPS = 1e-6f;
constexpr float QSCALE_F = 0.088388347648318440f * 1.4426950408889634f;
constexpr int NWAVES = 8, NTHREADS = 512;

constexpr size_t MiB = 1u << 20;
constexpr size_t WS_PART = 0;
constexpr size_t WS_BAR  = 768 * 1024;
constexpr int PANEL_CNT_WORD = 4096, TT_QUEUE_WORD = 7168; constexpr size_t CTL_BYTES = 32768;
constexpr size_t WS_GATE = 1 * MiB;
constexpr size_t WS_SSQ  = 2 * MiB;
constexpr size_t WS_WIN  = 4 * MiB;
constexpr size_t WS_WOUT = 30 * MiB;
constexpr size_t WS_H    = 38 * MiB;
constexpr size_t WS_Q    = 72 * MiB;
constexpr size_t WS_K    = 88 * MiB;
constexpr size_t WS_V    = 93 * MiB;
constexpr size_t WS_GA   = 98 * MiB;
constexpr size_t WS_U    = 114 * MiB;
constexpr size_t WS_G    = 130 * MiB;
constexpr size_t WS_MIX  = 146 * MiB;
constexpr size_t WS_END  = 178 * MiB;

constexpr int RING_BYTES = 131072, XCH_OFF = RING_BYTES, MISC_OFF = XCH_OFF + 12288, LDS_BYTES = 147456;

__device__ __forceinline__ unsigned cvt_pk_bf16(float lo, float hi) { unsigned r; asm volatile("v_cvt_pk_bf16_f32 %0, %1, %2" : "=v"(r) : "v"(lo), "v"(hi)); return r; }
__device__ __forceinline__ float bf2f(unsigned short h) { return __builtin_bit_cast(float, (unsigned)h << 16); }
__device__ __forceinline__ float bflo(unsigned w) { return __builtin_bit_cast(float, w << 16); }
__device__ __forceinline__ float bfhi(unsigned w) { return __builtin_bit_cast(float, w & 0xffff0000u); }
__device__ __forceinline__ float silu_f(float x) { return x * __builtin_amdgcn_rcpf(1.f + __builtin_amdgcn_exp2f(-1.4426950408889634f * x)); }
__device__ __forceinline__ float silu_acc(float x) { return x * __builtin_amdgcn_rcpf(1.f + __builtin_amdgcn_exp2f(-1.4426950408889634f * x)); }
__device__ __forceinline__ float wave_sum(float v) {
#pragma unroll
    for (int o = 1; o < 64; o <<= 1) v += __shfl_xor(v, o);
    return v;
}
__device__ __forceinline__ int opaque_tid(int wave_s) { int l = __builtin_amdgcn_mbcnt_hi(~0u, __builtin_amdgcn_mbcnt_lo(~0u, 0u)); asm volatile("" : "+v"(l)); return wave_s * 64 + l; }
template <int N> __device__ __forceinline__ float row_ror(float v) { return __builtin_bit_cast(float, __builtin_amdgcn_update_dpp(0, __builtin_bit_cast(int, v), 0x120 + N, 0xf, 0xf, false)); }
#define LDS_WAIT() asm volatile("s_waitcnt lgkmcnt(0)" ::: "memory")

namespace pg8 {
constexpr int BM = 256, BK = 64, HALF = 128, HTB = HALF * BK * 2, STAGE_BYTES = 8 * HTB, NXCD = 8, WGM = 8;
__host__ __device__ __forceinline__ int lds_byte(int r, int c) { const int st = (r >> 4) * 2 + (c >> 5), rr = r & 15, cc = c & 31, ob = rr * 64 + cc * 2; return st * 1024 + (ob ^ (((ob >> 9) & 1) << 5)); }
__host__ __device__ __forceinline__ void stage_rc(int b, int& R, int& C) { const int st = b / 1024, sb = b % 1024, swz = sb ^ (((sb >> 9) & 1) << 5); R = (st >> 1) * 16 + swz / 64; C = (st & 1) * 32 + (swz % 64) / 2; }
__host__ __device__ __forceinline__ int perm32(int rho) { const int n = rho >> 4, i = rho & 15; return 8 * (i >> 2) + 4 * n + (i & 3); }

struct Unit { int pm, pn; };
struct Gemm { const bf16_t* A; const bf16_t* Bt; int M, N, K; };

template <int NM, int NN, int EXTRA = 0, int EPM0 = 0, int EPN0 = 0, int ENN = 1>
struct TileMap {
    static constexpr int nwg = NM * NN, ntot = nwg + EXTRA;
    __device__ static __forceinline__ void decode(int ui, Unit& u) {
        if (EXTRA > 0 && ui >= nwg) { const int j = ui - nwg; u.pm = EPM0 + j / ENN; u.pn = EPN0 + j % ENN; return; }
        int wgid = ui; { constexpr int q = nwg / NXCD, r = nwg % NXCD; const int xcd = wgid % NXCD, off = wgid / NXCD; wgid = (xcd < r ? xcd * (q + 1) : r * (q + 1) + (xcd - r) * q) + off; }
        constexpr int nig = WGM * NN; const int gid = wgid / nig, fm = gid * WGM, gsz = (NM - fm) < WGM ? (NM - fm) : WGM;
        u.pm = fm + ((wgid % nig) % gsz); u.pn = (wgid % nig) / gsz;
    }
};
template <class Map> struct StaticOrder {
    int G, c, limit;
    __device__ __forceinline__ void init(int G_, int c_, int limit_) { G = G_; c = c_; limit = limit_; }
    __device__ __forceinline__ bool next(int i, Unit& u) const { const int L = i * G + c; if (L >= limit) return false; Map::decode(L, u); return true; }
};
template <class Map> struct OneUnit {
    int ui;
    __device__ __forceinline__ bool next(int i, Unit& u) const { if (i != 0 || ui < 0) return false; Map::decode(ui, u); return true; }
};

template <class Epi, class Sched, int RH = -1, bool PROLOGUE = true, bool DRAIN = true>
__device__ __forceinline__ void gemm_phase(LAS unsigned char* lds, const Gemm g, const Sched& S, const Epi& E, int wave_s, const Unit* handoff = nullptr) {
    const int tid = opaque_tid(wave_s), wid = wave_s, lane = tid & 63, wr = wid >> 2, wc = wid & 3, fr = lane & 15, fq = lane >> 4;
    const int K = g.K, nt = K / BK;
    unsigned voffA[2], voffB[2];
#pragma unroll
    for (int i = 0; i < 2; ++i) { int R, C; stage_rc(tid * 16 + i * 8192, R, C); const int Rb = (R & ~31) + perm32(R & 31);
        voffA[i] = (unsigned)(R * K + C) * 2u; voffB[i] = (unsigned)(Rb * K + C) * 2u; }
    const size_t kstep = (size_t)(BK * 2);
    const size_t hstep = (size_t)HALF * K * 2;
    const size_t tstep = 2 * hstep;
    const unsigned ldsw = (unsigned)wid * 1024u;
    const int aoff = lds_byte(wr * 64 + fr, fq * 8), boff = lds_byte(wc * 32 + fr, fq * 8);
#define PG8_SA(b, h) (((b) * 2 + (h)) * HTB)
#define PG8_SB(b, h) ((4 + (b) * 2 + (h)) * HTB)
#define PG8_STAGE(bufoff, gbase, voff) do { _Pragma("unroll") for (int _i = 0; _i < 2; ++_i) \
        __builtin_amdgcn_global_load_lds((const unsigned*)((const char*)(gbase) + (voff)[_i]), (LAS unsigned*)(lds + (bufoff) + ldsw + _i * 8192), 16, 0, 0); } while (0)
#define PG8_LDA(dst, b, h) do { _Pragma("unroll") for (int m = 0; m < 4; ++m) _Pragma("unroll") for (int k = 0; k < 2; ++k) dst[m][k] = *(const LAS bf16x8*)(lds + PG8_SA(b, h) + aoff + m * 2048 + k * 1024); } while (0)
#define PG8_LDB(dst, b, h) do { _Pragma("unroll") for (int n = 0; n < 2; ++n) _Pragma("unroll") for (int k = 0; k < 2; ++k) dst[n][k] = *(const LAS bf16x8*)(lds + PG8_SB(b, h) + boff + n * 2048 + k * 1024); } while (0)
#define PG8_MMA(ai, bj, At, Bt) do { __builtin_amdgcn_s_setprio(1); _Pragma("unroll") for (int m = 0; m < 4; ++m) _Pragma("unroll") for (int n = 0; n < 2; ++n) _Pragma("unroll") for (int k = 0; k < 2; ++k) \
        acc[ai][bj][m][n] = __builtin_amdgcn_mfma_f32_16x16x32_bf16(Bt[n][k], At[m][k], acc[ai][bj][m][n], 0, 0, 0); __builtin_amdgcn_s_setprio(0); } while (0)
#define PG8_WAIT_V(n) asm volatile("s_waitcnt vmcnt(" #n ")" ::: "memory")
#define PG8_WAIT_L(n) asm volatile("s_waitcnt lgkmcnt(" #n ")" ::: "memory")
#define PG8_BAR __builtin_amdgcn_s_barrier()
#define PG8_SCHED __builtin_amdgcn_sched_barrier(0)
    Unit cur, nxt; int ui = 0;
    if (!S.next(0, cur)) return;
    f32x4 acc[2][2][4][2];
#pragma unroll
    for (int a = 0; a < 2; ++a)
#pragma unroll
        for (int b = 0; b < 2; ++b)
#pragma unroll
            for (int m = 0; m < 4; ++m)
#pragma unroll
                for (int n = 0; n < 2; ++n) acc[a][b][m][n] = (f32x4){0.f, 0.f, 0.f, 0.f};
    bf16x8 At[4][2], B0[2][2], B1[2][2];
    const char* cA = (const char*)g.A + (size_t)cur.pm * tstep; const char* cB = (const char*)g.Bt + (size_t)cur.pn * tstep;
    if constexpr (PROLOGUE) {
    PG8_STAGE(PG8_SB(0, 0), cB, voffB); PG8_STAGE(PG8_SB(0, 1), cB + hstep, voffB); PG8_STAGE(PG8_SA(0, 0), cA, voffA); PG8_STAGE(PG8_SA(0, 1), cA + hstep, voffA);
    if (wr == 1) PG8_BAR;
    PG8_WAIT_V(2); PG8_BAR;
    PG8_STAGE(PG8_SB(1, 0), cB + kstep, voffB); PG8_STAGE(PG8_SA(1, 0), cA + kstep, voffA); PG8_STAGE(PG8_SB(1, 1), cB + hstep + kstep, voffB);
    PG8_WAIT_V(6); PG8_BAR;
    }
    for (;;) {
        const bool has_next = S.next(ui + 1, nxt);
        constexpr bool do0 = RH != 1, do1 = RH != 0;
        const bool chain = !has_next && !DRAIN && handoff != nullptr;
        const Unit pre = chain ? *handoff : nxt; const bool has_pref = has_next || chain;
        const char* nA = has_pref ? (const char*)g.A + (size_t)pre.pm * tstep : cA; const char* nB = has_pref ? (const char*)g.Bt + (size_t)pre.pn * tstep : cB;
        for (int t = 0; t < nt; t += 2) {
            const bool last = (t == nt - 2);
            const char* a1 = cA + (size_t)(t + 1) * kstep;
            const char* a2 = last ? nA : cA + (size_t)(t + 2) * kstep; const char* b2 = last ? nB : cB + (size_t)(t + 2) * kstep;
            const char* a3 = a2 + kstep; const char* b3 = b2 + kstep;
            PG8_LDB(B0, 0, 0); PG8_LDB(B1, 0, 1); PG8_SCHED; if (do0) PG8_LDA(At, 0, 0); PG8_STAGE(PG8_SA(1, 1), a1 + hstep, voffA);
            PG8_WAIT_V(8); PG8_WAIT_L(0); PG8_BAR; if (do0) { PG8_MMA(0, 0, At, B0); PG8_MMA(0, 1, At, B1); } PG8_BAR; PG8_SCHED;
            if (do1) PG8_LDA(At, 0, 1); PG8_STAGE(PG8_SB(0, 0), b2, voffB); PG8_STAGE(PG8_SB(0, 1), b2 + hstep, voffB); PG8_STAGE(PG8_SA(0, 0), a2, voffA);
            PG8_WAIT_V(8); PG8_WAIT_L(0); PG8_BAR; if (do1) { PG8_MMA(1, 0, At, B0); PG8_MMA(1, 1, At, B1); } PG8_BAR; PG8_SCHED;
            PG8_LDB(B0, 1, 0); PG8_LDB(B1, 1, 1); PG8_SCHED; if (do0) PG8_LDA(At, 1, 0); PG8_STAGE(PG8_SA(0, 1), a2 + hstep, voffA);
            PG8_WAIT_V(8); PG8_WAIT_L(0); PG8_BAR; if (do0) { PG8_MMA(0, 0, At, B0); PG8_MMA(0, 1, At, B1); } PG8_BAR; PG8_SCHED;
            if (do1) PG8_LDA(At, 1, 1); PG8_STAGE(PG8_SB(1, 0), b3, voffB); PG8_STAGE(PG8_SB(1, 1), b3 + hstep, voffB); PG8_STAGE(PG8_SA(1, 0), a3, voffA);
            PG8_WAIT_V(8); PG8_WAIT_L(0); PG8_BAR; if (do1) { PG8_MMA(1, 0, At, B0); PG8_MMA(1, 1, At, B1); } PG8_BAR; PG8_SCHED;
        }
        if (wr == 0) PG8_BAR;
        E.template run<RH>(acc, cur, wr, wc, fr, fq);
        if (!has_next) break;
#pragma unroll
        for (int a = 0; a < 2; ++a)
#pragma unroll
            for (int b = 0; b < 2; ++b)
#pragma unroll
                for (int m = 0; m < 4; ++m)
#pragma unroll
                    for (int n = 0; n < 2; ++n) acc[a][b][m][n] = (f32x4){0.f, 0.f, 0.f, 0.f};
        cur = nxt; cA = nA; cB = nB; ++ui;
        if (wr == 1) PG8_BAR;
    }
    if constexpr (DRAIN) { PG8_WAIT_V(0); PG8_BAR; }
    else { if (handoff != nullptr) { if (wr == 1) PG8_BAR; } else { PG8_WAIT_V(0); PG8_BAR; } }
#undef PG8_SA
#undef PG8_SB
#undef PG8_STAGE
#undef PG8_LDA
#undef PG8_LDB
#undef PG8_MMA
#undef PG8_WAIT_V
#undef PG8_WAIT_L
#undef PG8_BAR
#undef PG8_SCHED
}
}

__host__ __device__ __forceinline__ int win_src_col(int n) {
    if (n < 1280) { const int hb = n & ~127, s = n & 127, p = s >> 1, e = s & 1; return hb + (p < 32 ? p : p + 32) + 32 * e; }
    if (n < 2560) return n;
    const int t = n - 2560, ct = t >> 8, w = t & 255, half = w >> 7, s = w & 127, ch = ct * 64 + (s >> 1), e = s & 1;
    const int sec = half == 0 ? (e == 0 ? 3584 : 4608) : (e == 0 ? 2560 : 5632);
    return sec + ch;
}
struct EpiIn {
    unsigned char* ws; const float *qg, *kg, *convw; LAS float* P;
    template <int RH> __device__ __forceinline__ void run(f32x4 (&acc)[2][2][4][2], const pg8::Unit& u, int wr, int wc, int fr, int fq) const {
        asm volatile("" : "+v"(fr), "+v"(fq));
        const int pn = u.pn, pm = u.pm;
        bf16_t* const Q = (bf16_t*)(ws + WS_Q); bf16_t* const KB = (bf16_t*)(ws + WS_K); bf16_t* const VB = (bf16_t*)(ws + WS_V);
        bf16_t* const GA = (bf16_t*)(ws + WS_GA); bf16_t* const U = (bf16_t*)(ws + WS_U); bf16_t* const G = (bf16_t*)(ws + WS_G);
        const int rl0 = wr * 64 + fr;
        const bool isctx = pm >= 32;
        const int kvrow0 = isctx ? (pm - 32) * SKV : (pm >> 4) * SKV + CTX + (pm & 15) * 256;
        if (pn <= 4) {
            const bool isk = (pn == 4);
            const float* gw = isk ? kg : qg;
            float g1[2][2], g2[2][2], invf[2][2];
#pragma unroll
            for (int n = 0; n < 2; ++n)
#pragma unroll
                for (int jj = 0; jj < 2; ++jj) { const int p = 16 * wc + 4 * fq + 2 * n + jj, d1 = p < 32 ? p : p + 32;
                    g1[n][jj] = gw[d1]; g2[n][jj] = gw[d1 + 32]; invf[n][jj] = exp2f(-(float)(p & 31) * 0.41524101186092029f) * 0.15915494309189535f; }
#pragma unroll
            for (int ai = 0; ai < 2; ++ai) if (RH < 0 || ai == RH)
#pragma unroll
                for (int m = 0; m < 4; ++m)
#pragma unroll
                    for (int bj = 0; bj < 2; ++bj) { const f32x4 a = acc[ai][bj][m][0], b = acc[ai][bj][m][1];
                        float s = (a[0] * a[0] + a[1] * a[1]) + (a[2] * a[2] + a[3] * a[3]) + (b[0] * b[0] + b[1] * b[1]) + (b[2] * b[2] + b[3] * b[3]);
                        s += __shfl_xor(s, 16); s += __shfl_xor(s, 32);
                        if (fq == 0) P[((ai * 128 + rl0 + 16 * m) * 2 + bj) * 4 + wc] = s; }
            LDS_WAIT(); __builtin_amdgcn_s_barrier();
            bf16_t* obase; int ld;
            if (isk) { obase = KB + (size_t)kvrow0 * 256; ld = 256; } else { obase = Q + (size_t)pm * 256 * 1024 + pn * 256; ld = 1024; }
#pragma unroll
            for (int ai = 0; ai < 2; ++ai) if (RH < 0 || ai == RH)
#pragma unroll
                for (int m = 0; m < 4; ++m) { const int rl = ai * 128 + rl0 + 16 * m; const int t = (pm & 15) * 256 + rl;
                    const float pos = (float)(wc < 2 ? (t >> 6) : (t & 63));
                    float cs[2][2], sn[2][2];
#pragma unroll
                    for (int n = 0; n < 2; ++n)
#pragma unroll
                        for (int jj = 0; jj < 2; ++jj) { float rev = pos * invf[n][jj]; rev -= floorf(rev);
                            cs[n][jj] = isctx ? 1.f : __builtin_amdgcn_cosf(rev); sn[n][jj] = isctx ? 0.f : __builtin_amdgcn_sinf(rev); }
#pragma unroll
                    for (int bj = 0; bj < 2; ++bj) { const f32x4 pp = *(const LAS f32x4*)(P + (rl * 2 + bj) * 4);
                        const float rstd = rsqrtf(((pp[0] + pp[1]) + (pp[2] + pp[3])) * (1.f / 128.f) + EPS) * (isk ? 1.f : QSCALE_F);
                        unsigned w[4];
#pragma unroll
                        for (int n = 0; n < 2; ++n)
#pragma unroll
                            for (int jj = 0; jj < 2; ++jj) { const float x1 = acc[ai][bj][m][n][2 * jj] * rstd * g1[n][jj], x2 = acc[ai][bj][m][n][2 * jj + 1] * rstd * g2[n][jj];
                                w[2 * n + jj] = cvt_pk_bf16(x1 * cs[n][jj] - x2 * sn[n][jj], x2 * cs[n][jj] + x1 * sn[n][jj]); }
                        *(u32x4*)(obase + (size_t)rl * ld + bj * 128 + 32 * wc + 8 * fq) = (u32x4){w[0], w[1], w[2], w[3]}; } }
        } else if (pn == 5) {
#pragma unroll
            for (int ai = 0; ai < 2; ++ai) if (RH < 0 || ai == RH)
#pragma unroll
                for (int m = 0; m < 4; ++m) { const int rl = ai * 128 + rl0 + 16 * m;
#pragma unroll
                    for (int bj = 0; bj < 2; ++bj) { const f32x4 a = acc[ai][bj][m][0], b = acc[ai][bj][m][1];
                        *(u32x4*)(VB + (size_t)(kvrow0 + rl) * 256 + bj * 128 + 32 * wc + 8 * fq) = (u32x4){cvt_pk_bf16(a[0], a[1]), cvt_pk_bf16(a[2], a[3]), cvt_pk_bf16(b[0], b[1]), cvt_pk_bf16(b[2], b[3])}; } }
        } else if (pn < 10) {
#pragma unroll
            for (int ai = 0; ai < 2; ++ai) if (RH < 0 || ai == RH)
#pragma unroll
                for (int m = 0; m < 4; ++m) { const int rl = ai * 128 + rl0 + 16 * m;
#pragma unroll
                    for (int bj = 0; bj < 2; ++bj) { const f32x4 a = acc[ai][bj][m][0], b = acc[ai][bj][m][1];
                        *(u32x4*)(GA + (size_t)(pm * 256 + rl) * 1024 + (pn - 6) * 256 + bj * 128 + 32 * wc + 8 * fq) =
                            (u32x4){cvt_pk_bf16(silu_f(a[0]), silu_f(a[1])), cvt_pk_bf16(silu_f(a[2]), silu_f(a[3])), cvt_pk_bf16(silu_f(b[0]), silu_f(b[1])), cvt_pk_bf16(silu_f(b[2]), silu_f(b[3]))}; } }
        } else {
            const int cl = 16 * wc + 4 * fq, ch0 = (pn - 10) * 64 + cl;
            bf16_t* const MIXp = (bf16_t*)(ws + WS_MIX);
            float cw0[4], cw1[4], cw2[4];
#pragma unroll
            for (int q = 0; q < 4; ++q) { cw0[q] = convw[ch0 + q]; cw1[q] = convw[CW + ch0 + q]; cw2[q] = convw[2 * CW + ch0 + q]; }
            LAS float* E = P + 2048;
#pragma unroll
            for (int ai = 0; ai < 2; ++ai) if (RH < 0 || ai == RH) {
#pragma unroll
                for (int q = 0; q < 4; ++q) { const f32x4 cf = acc[ai][0][0][q >> 1], cl4 = acc[ai][0][3][q >> 1];
                    if (fr == 0)  E[((ai * 2 + wr) * 2 + 0) * 64 + cl + q] = cf[2 * (q & 1)] * cf[2 * (q & 1) + 1];
                    if (fr == 15) E[((ai * 2 + wr) * 2 + 1) * 64 + cl + q] = cl4[2 * (q & 1)] * cl4[2 * (q & 1) + 1]; } }
            LDS_WAIT(); __builtin_amdgcn_s_barrier(); asm volatile("" ::: "memory");
#pragma unroll
            for (int ai = 0; ai < 2; ++ai) if (RH < 0 || ai == RH) {
                float u[4][4], g[4][4];
#pragma unroll
                for (int m = 0; m < 4; ++m)
#pragma unroll
                    for (int q = 0; q < 4; ++q) { const f32x4 c = acc[ai][0][m][q >> 1], d = acc[ai][1][m][q >> 1];
                        u[m][q] = c[2 * (q & 1)] * c[2 * (q & 1) + 1]; g[m][q] = d[2 * (q & 1)] * silu_f(d[2 * (q & 1) + 1]); }
                float eprev[4], enext[4];
#pragma unroll
                for (int q = 0; q < 4; ++q) { eprev[q] = E[((ai * 2 + 0) * 2 + 1) * 64 + cl + q]; enext[q] = E[((ai * 2 + 1) * 2 + 0) * 64 + cl + q]; }
#pragma unroll
                for (int m = 0; m < 4; ++m) { const int rl = 64 * wr + 16 * m + fr;
                    const size_t row = (size_t)pm * 256 + ai * 128 + rl;
                    float o[4];
#pragma unroll
                    for (int q = 0; q < 4; ++q) {
                        const float sp = row_ror<1>(u[m][q]), spb = (m > 0) ? row_ror<1>(u[m > 0 ? m - 1 : 0][q]) : eprev[q];
                        const float sn = row_ror<15>(u[m][q]), snb = (m < 3) ? row_ror<15>(u[m < 3 ? m + 1 : 3][q]) : enext[q];
                        const float pv = (fr == 0) ? spb : sp, nx = (fr == 15) ? snb : sn;
                        o[q] = g[m][q] * (cw0[q] * pv + cw1[q] * u[m][q] + cw2[q] * nx); }
                    if (rl != 0 && rl != 127) *(u32x2*)(MIXp + row * DM + AW + ch0) = (u32x2){cvt_pk_bf16(o[0], o[1]), cvt_pk_bf16(o[2], o[3])};
                    if (rl <= 1 || rl >= 126) *(u32x2*)(U + row * CW + ch0) = (u32x2){cvt_pk_bf16(u[m][0], u[m][1]), cvt_pk_bf16(u[m][2], u[m][3])};
                    if (rl == 0 || rl == 127) *(u32x2*)(G + row * CW + ch0) = (u32x2){cvt_pk_bf16(g[m][0], g[m][1]), cvt_pk_bf16(g[m][2], g[m][3])}; }
            }
        }
    }
};

__device__ __forceinline__ unsigned xch_ld(unsigned* p)              { return __hip_atomic_load(p, __ATOMIC_RELAXED, __HIP_MEMORY_SCOPE_AGENT); }
__device__ __forceinline__ unsigned xch_add(unsigned* p, unsigned v) { return __hip_atomic_fetch_add(p, v, __ATOMIC_RELAXED, __HIP_MEMORY_SCOPE_AGENT); }
struct EpiOut {
    const float* x; const float* fg; float* out; unsigned char* ws;
    template <int RH> __device__ __forceinline__ void run(f32x4 (&acc)[2][2][4][2], const pg8::Unit& u, int wr, int wc, int fr, int fq) const {
        static_assert(RH < 0, "whole tiles only");
        const int pm = u.pm, pn = u.pn, b = pm >> 4;
        const float* const gate = (const float*)(ws + WS_GATE); float* const ssq = (float*)(ws + WS_SSQ); unsigned* const cnt = (unsigned*)(ws + WS_BAR) + PANEL_CNT_WORD;
        const int col0 = pn * 256 + 32 * wc + 8 * fq;
        {
            f32x4 gt[2][2];
#pragma unroll
            for (int bj = 0; bj < 2; ++bj)
#pragma unroll
                for (int n = 0; n < 2; ++n) gt[bj][n] = *(const f32x4*)(gate + b * DM + col0 + bj * 128 + 4 * n);
#pragma unroll
            for (int ai = 0; ai < 2; ++ai)
#pragma unroll
                for (int m = 0; m < 4; ++m) { const int row = pm * 256 + ai * 128 + wr * 64 + 16 * m + fr; float ss = 0.f;
#pragma unroll
                    for (int bj = 0; bj < 2; ++bj)
#pragma unroll
                        for (int n = 0; n < 2; ++n) { const f32x4 xv = *(const f32x4*)(x + (size_t)row * DM + col0 + bj * 128 + 4 * n); const f32x4 y = xv + gt[bj][n] * acc[ai][bj][m][n];
                            acc[ai][bj][m][n] = y; ss += (y[0] * y[0] + y[1] * y[1]) + (y[2] * y[2] + y[3] * y[3]); }
                    ss += __shfl_xor(ss, 16); ss += __shfl_xor(ss, 32);
                    if (fq == 0) __hip_atomic_store((unsigned*)ssq + (size_t)row * 32 + pn * 4 + wc, __float_as_uint(ss), __ATOMIC_RELAXED, __HIP_MEMORY_SCOPE_AGENT); }
        }
        asm volatile("s_waitcnt vmcnt(0)" ::: "memory");
        __syncthreads();
        if (wr == 0 && wc == 0 && fr == 0 && fq == 0) {
            unsigned* c = cnt + 64 * pm;
            (void)xch_add(c, 1u);
            unsigned sp = 0u; while (xch_ld(c) < 8u) { __builtin_amdgcn_s_sleep(1); if (++sp > (1u << 20)) break; }
        }
        __syncthreads();
        f32x4 fgv[2][2];
#pragma unroll
        for (int bj = 0; bj < 2; ++bj)
#pragma unroll
            for (int n = 0; n < 2; ++n) fgv[bj][n] = *(const f32x4*)(fg + col0 + bj * 128 + 4 * n);
#pragma unroll
        for (int ai = 0; ai < 2; ++ai)
#pragma unroll
            for (int m = 0; m < 4; ++m) { const int row = pm * 256 + ai * 128 + wr * 64 + 16 * m + fr;
                const unsigned long long* p = (const unsigned long long*)(ssq + (size_t)row * 32 + 8 * fq);
                const unsigned long long q0 = __hip_atomic_load(p, __ATOMIC_RELAXED, __HIP_MEMORY_SCOPE_AGENT), q1 = __hip_atomic_load(p + 1, __ATOMIC_RELAXED, __HIP_MEMORY_SCOPE_AGENT),
                                         q2 = __hip_atomic_load(p + 2, __ATOMIC_RELAXED, __HIP_MEMORY_SCOPE_AGENT), q3 = __hip_atomic_load(p + 3, __ATOMIC_RELAXED, __HIP_MEMORY_SCOPE_AGENT);
#define LOF(q) __uint_as_float((unsigned)(q))
#define HIF(q) __uint_as_float((unsigned)((q) >> 32))
                float s = ((LOF(q0) + HIF(q0)) + (LOF(q1) + HIF(q1))) + ((LOF(q2) + HIF(q2)) + (LOF(q3) + HIF(q3)));
#undef LOF
#undef HIF
                s += __shfl_xor(s, 16); s += __shfl_xor(s, 32);
                const float rstd = rsqrtf(s * (1.f / DM) + EPS);
#pragma unroll
                for (int bj = 0; bj < 2; ++bj)
#pragma unroll
                    for (int n = 0; n < 2; ++n) __builtin_nontemporal_store(acc[ai][bj][m][n] * rstd * fgv[bj][n], (f32x4*)(out + (size_t)row * DM + col0 + bj * 128 + 4 * n)); }
    }
};

struct ConvFixHook {
    const bf16_t* Ub; const bf16_t* Gb; const float* convw; bf16_t* MIX; int e, tid;
    __device__ __forceinline__ void operator()() const {
        if (e >= 0 && tid < 128) { const int ch0 = tid * 8, m = (e >> 1) * 128 + ((e & 1) ? 127 : 0);
            const u32x4 z = {0u, 0u, 0u, 0u};
            const u32x4 up = ((m & (SEQ - 1)) == 0) ? z : *(const u32x4*)(Ub + (size_t)(m - 1) * CW + ch0);
            const u32x4 uc = *(const u32x4*)(Ub + (size_t)m * CW + ch0);
            const u32x4 un = ((m & (SEQ - 1)) == SEQ - 1) ? z : *(const u32x4*)(Ub + (size_t)(m + 1) * CW + ch0);
            const u32x4 gg = *(const u32x4*)(Gb + (size_t)m * CW + ch0);
            unsigned o[4];
#pragma unroll
            for (int q = 0; q < 4; ++q) {
                const float w0l = convw[ch0 + 2 * q], w0h = convw[ch0 + 2 * q + 1], w1l = convw[CW + ch0 + 2 * q], w1h = convw[CW + ch0 + 2 * q + 1], w2l = convw[2 * CW + ch0 + 2 * q], w2h = convw[2 * CW + ch0 + 2 * q + 1];
                const float lo = bflo(gg[q]) * (w0l * bflo(up[q]) + w1l * bflo(uc[q]) + w2l * bflo(un[q]));
                const float hi = bfhi(gg[q]) * (w0h * bfhi(up[q]) + w1h * bfhi(uc[q]) + w2h * bfhi(un[q]));
                o[q] = cvt_pk_bf16(lo, hi); }
            *(u32x4*)(MIX + (size_t)m * DM + AW + ch0) = (u32x4){o[0], o[1], o[2], o[3]}; }
    }
};

namespace att {
constexpr int D = 128, QBLK = 32, KVBLK = 64;
constexpr float SCALE = 0.088388347648318440f, QSCALE = SCALE * 1.4426950408889634f;
constexpr int LDQ = 1024, LDK = 256;
constexpr int NBUF = 3;
constexpr size_t SHM_V = KVBLK * D * 2, SHM_K = KVBLK * D * 2, SHM_ATTN = NBUF * (SHM_V + SHM_K) + NWAVES * 64 * 4;
constexpr int OST_PITCH = 272, OST_WAVE = 32 * OST_PITCH;
constexpr size_t WS_OFF = NBUF * (SHM_V + SHM_K);
static_assert(WS_OFF >= 8 * (size_t)OST_WAVE, "O staging below the l words");
#define KSWZ(row, colB) ((row) * 256 + ((colB) ^ (((row) & 7) << 4)))
#define SBAR() __builtin_amdgcn_sched_barrier(0)
__device__ __forceinline__ int crow(int r, int hi) { return (r & 3) + 8 * (r >> 2) + 4 * hi; }
__device__ __forceinline__ void expHalf(f32x16& p) {
#pragma unroll
  for (int r = 0; r < 16; ++r) p[r] = __builtin_amdgcn_exp2f(p[r]);
}
__device__ __forceinline__ void finishSM(f32x16& p0, f32x16& p1, float& l_reg, bf16x8& pa0, bf16x8& pa1, bf16x8& pa2, bf16x8& pa3) {
  expHalf(p1);
  float ps = 0;
#pragma unroll
  for (int r = 0; r < 16; ++r) ps += p0[r];
#pragma unroll
  for (int r = 0; r < 16; ++r) ps += p1[r];
  { auto rr = __builtin_amdgcn_permlane32_swap(__float_as_uint(ps), __float_as_uint(ps), false, false);
    ps = __uint_as_float(rr[0]) + __uint_as_float(rr[1]); }
  l_reg += ps;
#define PK4(P, BASE, OUT) do { unsigned a0 = cvt_pk_bf16(P[BASE + 0], P[BASE + 1]), a1 = cvt_pk_bf16(P[BASE + 2], P[BASE + 3]);   \
    unsigned b0 = cvt_pk_bf16(P[BASE + 4], P[BASE + 5]), b1 = cvt_pk_bf16(P[BASE + 6], P[BASE + 7]);                              \
    auto r0 = __builtin_amdgcn_permlane32_swap(a0, b0, false, false); auto r1 = __builtin_amdgcn_permlane32_swap(a1, b1, false, false); \
    u32x4 w = {r0[0], r1[0], r0[1], r1[1]}; OUT = *reinterpret_cast<bf16x8*>(&w); } while (0)
  PK4(p0, 0, pa0); PK4(p0, 8, pa1); PK4(p1, 0, pa2); PK4(p1, 8, pa3);
#undef PK4
}
__device__ __forceinline__ void qkt(f32x16& p0, f32x16& p1, const char* Ks, const bf16x8* qr, int r32, int hi, float init) {
#pragma unroll
  for (int r = 0; r < 16; ++r) { p0[r] = init; p1[r] = init; }
#define KLD(d0, half) (*reinterpret_cast<const bf16x8*>(Ks + KSWZ((half) * 32 + r32, ((d0) * 16 + hi * 8) * 2)))
  bf16x8 a0 = KLD(0, 0), a1 = KLD(0, 1);
  __builtin_amdgcn_s_setprio(1);
#pragma unroll
  for (int d0 = 0; d0 < 8; ++d0) {
    bf16x8 n0 = a0, n1 = a1;
    if (d0 < 7) { n0 = KLD(d0 + 1, 0); n1 = KLD(d0 + 1, 1); }
    p0 = __builtin_amdgcn_mfma_f32_32x32x16_bf16(a0, qr[d0], p0, 0, 0, 0);
    p1 = __builtin_amdgcn_mfma_f32_32x32x16_bf16(a1, qr[d0], p1, 0, 0, 0);
    a0 = n0; a1 = n1; }
  __builtin_amdgcn_s_setprio(0);
#undef KLD
}
__device__ __forceinline__ int v_st(int k, int c) { const int kk = (k & ~0xC) | ((k & 4) << 1) | ((k & 8) >> 1); return ((kk >> 3) * 4 + (c >> 5)) * 512 + ((kk & 7) * 32 + (c & 31)) * 2; }
__device__ __forceinline__ int v_rd_base(int lane) { return ((lane & 3) << 3) | (((lane >> 2) & 3) << 6) | (((lane >> 4) & 1) << 5) | (((lane >> 5) & 1) << 8); }
constexpr int v_rd_off(int d0, int ks, int half) { return d0 * 512 + ks * 4096 + half * 2048; }
template <int OFF> __device__ __forceinline__ s16x4 tr_read(int vb) {
  s16x4 r; asm volatile("ds_read_b64_tr_b16 %0, %1 offset:%2" : "=&v"(r) : "v"(vb), "i"(OFF) : "memory"); return r;
}
struct VFrag { s16x4 l0, h0, l1, h1, l2, h2, l3, h3; };
template <int D0> __device__ __forceinline__ void pv_rd(VFrag& f, int vb) {
  f.l0 = tr_read<v_rd_off(D0, 0, 0)>(vb); f.h0 = tr_read<v_rd_off(D0, 0, 1)>(vb); f.l1 = tr_read<v_rd_off(D0, 1, 0)>(vb); f.h1 = tr_read<v_rd_off(D0, 1, 1)>(vb);
  f.l2 = tr_read<v_rd_off(D0, 2, 0)>(vb); f.h2 = tr_read<v_rd_off(D0, 2, 1)>(vb); f.l3 = tr_read<v_rd_off(D0, 3, 0)>(vb); f.h3 = tr_read<v_rd_off(D0, 3, 1)>(vb);
}
__device__ __forceinline__ void pv_mm(f32x16& od, const VFrag& f, bf16x8 pa0, bf16x8 pa1, bf16x8 pa2, bf16x8 pa3) {
#define PK(L, H) (bf16x8){L[0], L[1], L[2], L[3], H[0], H[1], H[2], H[3]}
  __builtin_amdgcn_s_setprio(1);
  od = __builtin_amdgcn_mfma_f32_32x32x16_bf16(pa0, PK(f.l0, f.h0), od, 0, 0, 0);
  od = __builtin_amdgcn_mfma_f32_32x32x16_bf16(pa1, PK(f.l1, f.h1), od, 0, 0, 0);
  od = __builtin_amdgcn_mfma_f32_32x32x16_bf16(pa2, PK(f.l2, f.h2), od, 0, 0, 0);
  od = __builtin_amdgcn_mfma_f32_32x32x16_bf16(pa3, PK(f.l3, f.h3), od, 0, 0, 0);
  __builtin_amdgcn_s_setprio(0);
#undef PK
}
__device__ __forceinline__ void pv_d0(f32x16* o, int vb, bf16x8 pa0, bf16x8 pa1, bf16x8 pa2, bf16x8 pa3) {
  VFrag fa, fb;
  pv_rd<0>(fa, vb); pv_rd<1>(fb, vb);
  asm volatile("s_waitcnt lgkmcnt(8)" ::: "memory"); SBAR(); pv_mm(o[0], fa, pa0, pa1, pa2, pa3); SBAR();
  pv_rd<2>(fa, vb);
  asm volatile("s_waitcnt lgkmcnt(8)" ::: "memory"); SBAR(); pv_mm(o[1], fb, pa0, pa1, pa2, pa3); SBAR();
  pv_rd<3>(fb, vb);
  asm volatile("s_waitcnt lgkmcnt(8)" ::: "memory"); SBAR(); pv_mm(o[2], fa, pa0, pa1, pa2, pa3); SBAR();
  asm volatile("s_waitcnt lgkmcnt(0)" ::: "memory"); SBAR(); pv_mm(o[3], fb, pa0, pa1, pa2, pa3);
}
template <class Hook>
__device__ __forceinline__ void attn_dense_body(const bf16_t* __restrict__ Qb, const bf16_t* __restrict__ Kh, const bf16_t* __restrict__ Vh,
                                                const bf16_t* __restrict__ GAb, bf16_t* __restrict__ MIXb, const float* __restrict__ qg, const float* __restrict__ kg, int seq, char* lds, int wave_s, const Hook& hook) {
  const int tid = opaque_tid(wave_s), wid = wave_s, lane = tid & 63, r32 = lane & 31, hi = lane >> 5;
  char* V_lds = lds; char* K_lds = lds + NBUF * SHM_V;
#define TO_LAS(p) ((LAS unsigned char*)(unsigned)(uintptr_t)(p))
  float* ws = (float*)(lds + WS_OFF) + wid * 64; float* li_l = ws;
  float l_reg = 0; f32x16 o[4] = {}; bf16x8 qr[8];
  float init;
  { float gq = fmaxf(fabsf(qg[lane]), fabsf(qg[lane + 64])), gk = fmaxf(fabsf(kg[lane]), fabsf(kg[lane + 64]));
#pragma unroll
    for (int ofs = 1; ofs < 64; ofs <<= 1) { gq = fmaxf(gq, __shfl_xor(gq, ofs)); gk = fmaxf(gk, __shfl_xor(gk, ofs)); }
    init = -(QSCALE * 128.f * 1.02f) * gq * gk; }
  const bf16_t* Qw = Qb + (long)(wid * QBLK + r32) * LDQ + hi * 8;
#pragma unroll
  for (int d0 = 0; d0 < 8; ++d0) qr[d0] = *reinterpret_cast<const bf16x8*>(Qw + d0 * 16);
  const int vb0 = (int)(uintptr_t)V_lds + v_rd_base(lane);
  int koff[2], voff[2];
#pragma unroll
  for (int i = 0; i < 2; ++i) { const int p = (i * 8 + wid) * 64 + lane;
    { const int row = p >> 4, c = (p & 15) ^ (row & 7); koff[i] = row * LDK + c * 8; }
    { const int S = p >> 5, within = p & 31, kk = (S >> 2) * 8 + (within >> 2), k = (kk & ~0xC) | ((kk & 4) << 1) | ((kk & 8) >> 1), col = (S & 3) * 32 + (within & 3) * 8;
      voff[i] = k * LDK + col; } }
#define DMA_TILE(b, k0) do { _Pragma("unroll") for (int _i = 0; _i < 2; ++_i) { \
    __builtin_amdgcn_global_load_lds((const unsigned*)(Kh + (long)(k0) * LDK + koff[_i]), (LAS unsigned*)(TO_LAS(K_lds) + (b) * (int)SHM_K + (_i * 8 + wid) * 1024), 16, 0, 0); \
    __builtin_amdgcn_global_load_lds((const unsigned*)(Vh + (long)(k0) * LDK + voff[_i]), (LAS unsigned*)(TO_LAS(V_lds) + (b) * (int)SHM_V + (_i * 8 + wid) * 1024), 16, 0, 0); } } while (0)
  f32x16 pA0, pA1, pB0, pB1; bf16x8 pa0, pa1, pa2, pa3; const int NT = seq / KVBLK;
  int bc = 0, bn = 1, bw = 2;
  DMA_TILE(0, 0); DMA_TILE(1, KVBLK);
  hook();
  __syncthreads();
  qkt(pA0, pA1, K_lds, qr, r32, hi, init); expHalf(pA0);
#define ROT() do { const int _t = bc; bc = bn; bn = bw; bw = _t; } while (0)
#define ITER(PC0, PC1, PN0, PN1, t) do { __syncthreads(); \
    if ((t) + 2 < NT) DMA_TILE(bw, ((t) + 2) * KVBLK); \
    SBAR(); qkt(PN0, PN1, K_lds + bn * (int)SHM_K, qr, r32, hi, init); finishSM(PC0, PC1, l_reg, pa0, pa1, pa2, pa3); SBAR(); \
    pv_d0(o, vb0 + bc * (int)SHM_V, pa0, pa1, pa2, pa3); expHalf(PN0); ROT(); } while (0)
  for (int t = 0; t + 2 < NT; t += 2) { ITER(pA0, pA1, pB0, pB1, t); ITER(pB0, pB1, pA0, pA1, t + 1); }
  ITER(pA0, pA1, pB0, pB1, NT - 2);
  finishSM(pB0, pB1, l_reg, pa0, pa1, pa2, pa3); SBAR();
  pv_d0(o, vb0 + bc * (int)SHM_V, pa0, pa1, pa2, pa3);
#undef ITER
#undef ROT
#undef DMA_TILE
  if (hi == 0) li_l[r32] = l_reg; asm volatile("s_waitcnt lgkmcnt(0)" ::: "memory");
  __syncthreads();
  { char* ost = lds + wid * OST_WAVE;
#pragma unroll
    for (int r = 0; r < 16; ++r) { const int orow = crow(r, hi); const float rl = __builtin_amdgcn_rcpf(li_l[orow]);
#pragma unroll
      for (int d0 = 0; d0 < 4; ++d0) *(bf16_t*)(ost + orow * OST_PITCH + (d0 * 32 + r32) * 2) = (bf16_t)(cvt_pk_bf16(o[d0][r] * rl, 0.f) & 0xffffu); }
    asm volatile("s_waitcnt lgkmcnt(0)" ::: "memory");
#pragma unroll
    for (int i = 0; i < 8; ++i) { const int id = i * 64 + lane, row = id >> 4, cc = id & 15; const long grow = wid * QBLK + row;
      const u32x4 ov = *(const u32x4*)(ost + row * OST_PITCH + cc * 16); const u32x4 gv = *(const u32x4*)(GAb + grow * 1024 + cc * 8);
      u32x4 w;
#pragma unroll
      for (int q = 0; q < 4; ++q) w[q] = cvt_pk_bf16(bflo(ov[q]) * bflo(gv[q]), bfhi(ov[q]) * bfhi(gv[q]));
      *(u32x4*)(MIXb + grow * 2048 + cc * 8) = w; }
  }
  __syncthreads();
}
#undef KSWZ
#undef SBAR
}

__device__ __forceinline__ void p0_adaln(const float* __restrict__ c, const float* __restrict__ cctx, const float* __restrict__ wmod, float* part, LAS float* red,
                                         int tid, int wave, int lane, int bid, int G) {
    for (int it = bid; it < 192; it += G) {
        const int sl = it % 24, kc = it / 24, col = sl * 256 + 4 * lane, k0 = kc * 256 + wave * 32;
        f32x4 wv[32];
#pragma unroll
        for (int i = 0; i < 32; ++i) wv[i] = __builtin_nontemporal_load((const f32x4*)(wmod + (size_t)(k0 + i) * 6144 + col));
        f32x4 a0 = {0.f, 0.f, 0.f, 0.f}, a1 = a0, a2 = a0;
#pragma unroll
        for (int i = 0; i < 32; ++i) { const int k = k0 + i; a0 += silu_acc(c[k]) * wv[i]; a1 += silu_acc(c[DM + k]) * wv[i]; a2 += silu_acc(cctx[k]) * wv[i]; }
        *(LAS f32x4*)(red + ((wave * 3 + 0) * 64 + lane) * 4) = a0; *(LAS f32x4*)(red + ((wave * 3 + 1) * 64 + lane) * 4) = a1; *(LAS f32x4*)(red + ((wave * 3 + 2) * 64 + lane) * 4) = a2;
        __syncthreads();
        if (tid < 192) { const int r = tid >> 6, l = tid & 63; f32x4 sm = {0.f, 0.f, 0.f, 0.f};
#pragma unroll
            for (int w = 0; w < 8; ++w) sm += *(const LAS f32x4*)(red + ((w * 3 + r) * 64 + l) * 4);
            *(f32x4*)(part + ((size_t)kc * 3 + r) * 6144 + sl * 256 + 4 * l) = sm; }
        __syncthreads();
    }
}
template <bool PERMUTE>
__device__ __forceinline__ void p0_transpose_item(const float* __restrict__ W, int K, int N, bf16_t* WT, LAS float* scr, int item, int lane) {
    const int nblk = N / 32, kb = item / nblk, nb = item % nblk, k0 = 64 * kb, n0 = 32 * nb;
    const int srcc = PERMUTE ? win_src_col(n0 + (lane & 31)) : n0 + (lane & 31);
    float tv[32];
#pragma unroll
    for (int i = 0; i < 32; ++i) tv[i] = __builtin_nontemporal_load(W + (size_t)(k0 + 2 * i + (lane >> 5)) * N + srcc);
#pragma unroll
    for (int i = 0; i < 32; ++i) scr[(2 * i + (lane >> 5)) * 33 + (lane & 31)] = tv[i];
    LDS_WAIT(); asm volatile("" ::: "memory");
    const int cch = lane & 7;
#pragma unroll
    for (int j = 0; j < 4; ++j) { const int n = (lane >> 3) + 8 * j; const LAS float* s = scr + (8 * cch) * 33 + n;
        u32x4 o; o.x = cvt_pk_bf16(s[0 * 33], s[1 * 33]); o.y = cvt_pk_bf16(s[2 * 33], s[3 * 33]); o.z = cvt_pk_bf16(s[4 * 33], s[5 * 33]); o.w = cvt_pk_bf16(s[6 * 33], s[7 * 33]);
        *(u32x4*)(WT + (size_t)(n0 + n) * K + k0 + 8 * cch) = o; }
    LDS_WAIT(); asm volatile("" ::: "memory");
}
template <int MODE> __host__ __device__ __forceinline__ void tt_map(int T, int j, int& src, int& dst) {
    if (MODE == 1 || (T >= 5 && T <= 9)) { src = T * 256 + j; dst = j; return; }
    if (T <= 4) { src = T * 256 + j; const int hh = j >> 7, d = j & 127; const int sl = d < 32 ? 2 * d : d < 64 ? 2 * (d - 32) + 1 : d < 96 ? 2 * (d - 32) : 2 * (d - 64) + 1; dst = hh * 128 + sl; return; }
    const int ct = T - 10, r = j >> 6, c = j & 63; const int sec = r == 0 ? 3584 : r == 1 ? 4608 : r == 2 ? 2560 : 5632; src = sec + 64 * ct + c; dst = (r >> 1) * 128 + 2 * c + (r & 1);
}
constexpr int TT_PITCH = 144;
constexpr int TT_TILE_BYTES = 256 * TT_PITCH;
template <int MODE> __device__ __forceinline__ void tt_load(const float* __restrict__ W, int N, int kb, int T, int wave, int lane, f32x4 (&v)[8]) {
    int src, dst; tt_map<MODE>(T, 4 * lane, src, dst); (void)dst;
#pragma unroll
    for (int i = 0; i < 8; ++i) v[i] = __builtin_nontemporal_load((const f32x4*)(W + (size_t)(kb * 64 + wave * 8 + i) * N + src));
}
template <int MODE> __device__ __forceinline__ void tt_to_lds(LAS unsigned char* tile, int T, int wave, int lane, const f32x4 (&v)[8]) {
#pragma unroll
    for (int c = 0; c < 4; ++c) { int src, dst; tt_map<MODE>(T, 4 * lane + c, src, dst); (void)src;
        *(LAS u32x4*)(tile + dst * TT_PITCH + 16 * wave) = (u32x4){cvt_pk_bf16(v[0][c], v[1][c]), cvt_pk_bf16(v[2][c], v[3][c]), cvt_pk_bf16(v[4][c], v[5][c]), cvt_pk_bf16(v[6][c], v[7][c])}; }
}
__device__ __forceinline__ void tt_store(const LAS unsigned char* tile, bf16_t* WT, int K, int kb, int T, int tid) {
#pragma unroll
    for (int q = 0; q < 4; ++q) { const int id = q * NTHREADS + tid, n = id >> 3, cc = id & 7;
        *(u32x4*)(WT + (size_t)(T * 256 + n) * K + kb * 64 + 8 * cc) = *(const LAS u32x4*)(tile + n * TT_PITCH + 16 * cc); }
}
template <int MODE> __device__ __forceinline__ void tt_run(const float* __restrict__ W, int K, int N, bf16_t* WT, int NT, unsigned* queue, int first, int stride,
                                                          LAS unsigned char* tile, volatile LAS unsigned* word, int tid, int wave, int lane) {
    const int ntiles = (K / 64) * NT;
    if (tid == 0) *word = queue ? atomicAdd(queue, 1u) : (unsigned)first;
    __syncthreads();
    int it = (int)*word, nstat = first;
    f32x4 v[8];
    if (it < ntiles) tt_load<MODE>(W, N, it / NT, it % NT, wave, lane, v);
    __syncthreads();
    while (it < ntiles) {
        const int kb = it / NT, T = it % NT;
        tt_to_lds<MODE>(tile, T, wave, lane, v);
        nstat += stride;
        if (tid == 0) *word = queue ? atomicAdd(queue, 1u) : (unsigned)nstat;
        __syncthreads();
        const int nx = (int)*word;
        if (nx < ntiles) tt_load<MODE>(W, N, nx / NT, nx % NT, wave, lane, v);
        tt_store(tile, WT, K, kb, T, tid);
        __syncthreads();
        it = nx;
    }
}

template <int NR>
__device__ __forceinline__ void h_rows(const float* __restrict__ x0, bf16_t* o0, const LAS float* AL, const LAS float* SL, int lane) {
    f32x4 v[NR][8]; float rstd[NR];
#pragma unroll
    for (int r = 0; r < NR; ++r)
#pragma unroll
        for (int j = 0; j < 8; ++j) v[r][j] = ((const f32x4*)(x0 + (size_t)r * DM))[lane + 64 * j];
#pragma unroll
    for (int r = 0; r < NR; ++r) { float s = 0.f;
#pragma unroll
        for (int j = 0; j < 8; ++j) s += (v[r][j][0] * v[r][j][0] + v[r][j][1] * v[r][j][1]) + (v[r][j][2] * v[r][j][2] + v[r][j][3] * v[r][j][3]);
        rstd[r] = rsqrtf(wave_sum(s) * (1.f / DM) + EPS); }
#pragma unroll
    for (int j = 0; j < 8; ++j) { const f32x4 a = *(const LAS f32x4*)(AL + 4 * lane + 256 * j), sh = *(const LAS f32x4*)(SL + 4 * lane + 256 * j);
#pragma unroll
        for (int r = 0; r < NR; ++r) { const f32x4 h = v[r][j] * rstd[r] * a + sh;
            *(u32x2*)(o0 + (size_t)r * DM + 4 * lane + 256 * j) = (u32x2){cvt_pk_bf16(h[0], h[1]), cvt_pk_bf16(h[2], h[3])}; } }
}

#define XB_TMO      128
#define XB_XCNT(j)  (256  + 64 * (j))
#define XB_XSUB(j)  (1280 + 64 * (j))
#define XB_XGEN(j)  (2304 + 64 * (j))
#define XB_TOP      3328
#define XB_TOPGEN   3392
#define XCD_BAR_WORDS 3456
#define XB_SPIN_CAP (1u << 18)
__device__ __forceinline__ unsigned xb_ld(unsigned* p)              { return __hip_atomic_load(p, __ATOMIC_RELAXED, __HIP_MEMORY_SCOPE_AGENT); }
__device__ __forceinline__ unsigned xb_add(unsigned* p, unsigned v) { return __hip_atomic_fetch_add(p, v, __ATOMIC_RELAXED, __HIP_MEMORY_SCOPE_AGENT); }
__device__ __forceinline__ unsigned xb_xcc_id() { return (unsigned)__builtin_amdgcn_s_getreg((3 << 11) | 20) & 0xFu; }
#define XB_SPIN(cond, bar) do { unsigned _sp = 0; while (cond) { __builtin_amdgcn_s_sleep(1); \
    if ((++_sp & 255u) == 0u) { if (xb_ld(&(bar)[XB_TMO])) break; if (_sp > XB_SPIN_CAP) { atomicAdd(&(bar)[XB_TMO], 1u); break; } } } } while (0)
struct XcdBarrier { unsigned* bar; unsigned x; volatile LAS unsigned* st; };
__device__ __forceinline__ XcdBarrier xcd_barrier_post(unsigned* bar, volatile LAS unsigned* st, bool leader) {
    XcdBarrier b; b.bar = bar; b.x = xb_xcc_id(); b.st = st;
    if (leader) (void)xb_add(&bar[XB_XCNT(b.x)], 1u);
    return b;
}
__device__ __forceinline__ void xcd_barrier_complete(unsigned* bar, unsigned x, unsigned& nloc, unsigned& nx) {
    const unsigned G = gridDim.x * gridDim.y * gridDim.z;
    unsigned sum, cnt, mine, sp = 0u;
    for (;;) {
        sum = 0u; cnt = 0u; mine = 0u;
#pragma unroll
        for (unsigned j = 0; j < 16; ++j) { const unsigned c = xb_ld(&bar[XB_XCNT(j)]); sum += c; cnt += (c > 0u) ? 1u : 0u; mine = (j == x) ? c : mine; }
        if (sum == G) break;
        __builtin_amdgcn_s_sleep(1);
        if ((++sp & 255u) == 0u) { if (xb_ld(&bar[XB_TMO])) break; if (sp > XB_SPIN_CAP) { atomicAdd(&bar[XB_TMO], 1u); break; } }
    }
    nloc = mine > 0u ? mine : 1u; nx = cnt > 0u ? cnt : 1u;
}
__device__ __forceinline__ void xcd_barrier(const XcdBarrier& b, bool leader) {
    asm volatile("s_waitcnt vmcnt(0)" ::: "memory");
    __syncthreads();
    if (leader) {
        unsigned* bar = b.bar;
        __builtin_amdgcn_s_waitcnt(0);
        unsigned nloc = b.st[0], nx = b.st[1];
        if (nloc == 0u) { xcd_barrier_complete(bar, b.x, nloc, nx); b.st[0] = nloc; b.st[1] = nx; }
        const unsigned old = xb_add(&bar[XB_XSUB(b.x)], 1u);
        const unsigned gen = old / nloc;
        if (old + 1u == (gen + 1u) * nloc) {
            __builtin_amdgcn_fence(__ATOMIC_RELEASE, "agent");
            asm volatile("s_waitcnt vmcnt(0)" ::: "memory");
            const unsigned og = xb_add(&bar[XB_TOP], 1u);
            const unsigned tg = og / nx;
            if (og + 1u == (tg + 1u) * nx) xb_add(&bar[XB_TOPGEN], 1u);
            else XB_SPIN(xb_ld(&bar[XB_TOPGEN]) == tg, bar);
            __builtin_amdgcn_fence(__ATOMIC_ACQUIRE, "agent");
            xb_add(&bar[XB_XGEN(b.x)], 1u);
            asm volatile("s_waitcnt vmcnt(0)" ::: "memory");
        } else {
            XB_SPIN(xb_ld(&bar[XB_XGEN(b.x)]) == gen, bar);
            __builtin_amdgcn_fence(__ATOMIC_ACQUIRE, "agent");
            asm volatile("s_waitcnt vmcnt(0)" ::: "memory");
        }
    }
    __syncthreads();
}

struct Args {
    const float *x, *c, *ctx, *cctx, *wmod, *bmod, *normg, *win, *qg, *kg, *convw, *wout, *fg;
    float* out; unsigned char* ws;
    int use_cg, pad;
};

__global__ void __launch_bounds__(NTHREADS, 2) fwd_megakernel(Args a) {
    extern __shared__ __attribute__((aligned(16))) unsigned char lds_raw[];
    cg::grid_group grid = cg::this_grid();
    LAS unsigned char* lds = (LAS unsigned char*)lds_raw;
    const int bid = blockIdx.x, G = gridDim.x;
    const int wave_s = __builtin_amdgcn_readfirstlane(threadIdx.x >> 6);
    const bool leader = (threadIdx.x == 0);
    volatile LAS unsigned* MISC = (volatile LAS unsigned*)(lds + MISC_OFF);
    if (threadIdx.x < 4) MISC[threadIdx.x] = 0u;
    __syncthreads();
    const XcdBarrier xbar = xcd_barrier_post((unsigned*)(a.ws + WS_BAR), MISC, leader);
#define GRID_SEAM() do { if (a.use_cg) grid.sync(); else xcd_barrier(xbar, threadIdx.x == 0); } while (0)
#define PHASE_IDS() const int tid = opaque_tid(wave_s), lane = tid & 63, wave = wave_s; (void)lane; (void)wave
    unsigned char* ws = a.ws;
    float* PART = (float*)(ws + WS_PART); float* GATE = (float*)(ws + WS_GATE); float* SSQ = (float*)(ws + WS_SSQ);
    bf16_t* WIN = (bf16_t*)(ws + WS_WIN); bf16_t* WOUT = (bf16_t*)(ws + WS_WOUT); bf16_t* H = (bf16_t*)(ws + WS_H);
    bf16_t* Qb = (bf16_t*)(ws + WS_Q); bf16_t* KB = (bf16_t*)(ws + WS_K); bf16_t* VB = (bf16_t*)(ws + WS_V);
    bf16_t* GA = (bf16_t*)(ws + WS_GA); bf16_t* Ub = (bf16_t*)(ws + WS_U); bf16_t* Gb = (bf16_t*)(ws + WS_G); bf16_t* MIX = (bf16_t*)(ws + WS_MIX);

    {
        PHASE_IDS();
        p0_adaln(a.c, a.cctx, a.wmod, PART, (LAS float*)lds, tid, wave, lane, bid, G);
        tt_run<0>(a.win, DM, NIN, WIN, NIN / 256, (unsigned*)(ws + WS_BAR) + TT_QUEUE_WORD, 0, 0, lds + 32768, (volatile LAS unsigned*)(lds + XCH_OFF), tid, wave, lane);
    }
    GRID_SEAM();

    {
        PHASE_IDS();
        LAS float* AL0 = (LAS float*)lds; LAS float* SL0 = AL0 + DM; LAS float* AL2 = SL0 + DM; LAS float* SL2 = AL2 + DM;
        for (int idx = bid * NTHREADS + tid; idx < NB * DM; idx += G * NTHREADS) { const int r = idx >> 11, n = (idx & (DM - 1)) + 2 * DM; float s = a.bmod[n];
#pragma unroll
            for (int kc = 0; kc < 8; ++kc) s += PART[((size_t)kc * 3 + r) * 6144 + n];
            GATE[idx] = s; }
        for (int ch = bid; ch < MLAT / 32; ch += G) {
            const int r = ch >> 7;
            __syncthreads();
            { const int n4 = 4 * tid;
                f32x4 sh0 = *(const f32x4*)(a.bmod + n4), sc0 = *(const f32x4*)(a.bmod + DM + n4), sh2 = sh0, sc2 = sc0;
#pragma unroll
                for (int kc = 0; kc < 8; ++kc) { const float* p = PART + (size_t)kc * 3 * 6144;
                    sh0 += *(const f32x4*)(p + r * 6144 + n4); sc0 += *(const f32x4*)(p + r * 6144 + DM + n4); sh2 += *(const f32x4*)(p + 2 * 6144 + n4); sc2 += *(const f32x4*)(p + 2 * 6144 + DM + n4); }
                const f32x4 gn = *(const f32x4*)(a.normg + n4);
                *(LAS f32x4*)(AL0 + n4) = gn * (1.f + sc0); *(LAS f32x4*)(SL0 + n4) = sh0; *(LAS f32x4*)(AL2 + n4) = gn * (1.f + sc2); *(LAS f32x4*)(SL2 + n4) = sh2;
            }
            __syncthreads();
            { const int m = ch * 32 + wave * 4; h_rows<4>(a.x + (size_t)m * DM, H + (size_t)m * DM, AL0, SL0, lane); }
            if (wave < 2) { const int mc = ch * 2 + wave; if (mc < MCTX) h_rows<1>(a.ctx + (size_t)mc * DM, H + (size_t)(MLAT + mc) * DM, AL2, SL2, lane); }
        }
        __syncthreads();
    }
    GRID_SEAM();

    {
        typedef pg8::TileMap<MLAT / 256, NIN / 256, 4, 32, 4, 2> MapIn;
        const int Rfull = MapIn::ntot / G, tail = MapIn::ntot - Rfull * G; const bool split = (2 * tail <= G);
        pg8::Gemm g{H, WIN, MALL, NIN, DM};
        EpiIn E{ws, a.qg, a.kg, a.convw, (LAS float*)(lds + XCH_OFF)};
        const bool has_tail = split && bid < 2 * tail;
        pg8::Unit tu; tu.pm = 0; tu.pn = 0; if (has_tail) MapIn::decode(Rfull * G + (bid >> 1), tu);
        { pg8::StaticOrder<MapIn> S; S.init(G, bid, split ? Rfull * G : MapIn::ntot);
          if (has_tail) pg8::gemm_phase<EpiIn, pg8::StaticOrder<MapIn>, -1, true, false>(lds, g, S, E, wave_s, &tu);
          else          pg8::gemm_phase<EpiIn, pg8::StaticOrder<MapIn>, -1>(lds, g, S, E, wave_s); }
        if (has_tail) { pg8::OneUnit<MapIn> S1{Rfull * G + (bid >> 1)};
            if (bid & 1) pg8::gemm_phase<EpiIn, pg8::OneUnit<MapIn>, 1, false, true>(lds, g, S1, E, wave_s);
            else         pg8::gemm_phase<EpiIn, pg8::OneUnit<MapIn>, 0, false, true>(lds, g, S1, E, wave_s); }
        { PHASE_IDS();
          const int first_idle = (2 * tail <= G) ? 2 * tail : tail, n_idle = first_idle == 0 ? G : G - first_idle, me = first_idle == 0 ? bid : bid - first_idle;
          if (me >= 0) tt_run<1>(a.wout, DM, DM, WOUT, DM / 256, nullptr, me, n_idle, lds + 32768, (volatile LAS unsigned*)(lds + XCH_OFF), tid, wave, lane); }
    }
    GRID_SEAM();

    {
        PHASE_IDS();
        if (bid < 256) {
            const int ui = bid;
            const int xq = ui & 7, idx = (ui >> 3) + 32 * (xq & 1), combo = xq >> 1, b = combo >> 1, kvh = combo & 1, h = kvh * 4 + (idx >> 4), qb = idx & 15;
            const size_t row0 = (size_t)b * SEQ + qb * 256;
            att::attn_dense_body(Qb + row0 * AW + h * HD, KB + (size_t)b * SKV * 256 + kvh * HD, VB + (size_t)b * SKV * 256 + kvh * HD,
                                 GA + row0 * AW + h * HD, MIX + row0 * DM + h * HD, a.qg, a.kg, SKV, (char*)lds_raw, wave_s,
                                 ConvFixHook{Ub, Gb, a.convw, MIX, bid < MLAT / 64 ? bid : -1, tid});
        }
    }
    GRID_SEAM();

    {
        typedef pg8::TileMap<MLAT / 256, DM / 256> MapOut;
        pg8::Gemm g{MIX, WOUT, MLAT, DM, DM}; pg8::OneUnit<MapOut> S{bid < MapOut::ntot ? bid : -1};
        EpiOut E{a.x, a.fg, a.out, ws};
        pg8::gemm_phase<EpiOut, pg8::OneUnit<MapOut>, -1>(lds, g, S, E, wave_s);
    }
}

extern "C" void kernel_launch(void* const* d_in, const int* in_sizes, int n_in, void* d_out, int out_size, void* d_ws, size_t ws_size, hipStream_t stream) {
    static int grid_blocks = 0;
    if (grid_blocks == 0) {
        if (n_in != 13 || in_sizes[0] != MLAT * DM || out_size != MLAT * DM || ws_size < WS_END) { fprintf(stderr, "kernel_launch: shape mismatch (n_in %d in0 %d out %d ws %zu)\n", n_in, n_in > 0 ? in_sizes[0] : -1, out_size, ws_size); grid_blocks = -1; return; }
        int dev = 0, cus = 0, per_cu = 0;
        hipGetDevice(&dev);
        hipDeviceGetAttribute(&cus, hipDeviceAttributeMultiprocessorCount, dev);
        if (hipFuncSetAttribute((const void*)fwd_megakernel, hipFuncAttributeMaxDynamicSharedMemorySize, LDS_BYTES) != hipSuccess) { fprintf(stderr, "kernel_launch: hipFuncSetAttribute failed\n"); grid_blocks = -1; return; }
        if (hipOccupancyMaxActiveBlocksPerMultiprocessor(&per_cu, (const void*)fwd_megakernel, NTHREADS, LDS_BYTES) != hipSuccess || per_cu < 1) { fprintf(stderr, "kernel_launch: occupancy query gave %d\n", per_cu); per_cu = 1; }
        (void)hipGetLastError();
        grid_blocks = cus * per_cu;
        if (grid_blocks > 256) grid_blocks = 256;
    }
    if (grid_blocks < 0) return;
    Args a{};
    a.x = (const float*)d_in[0]; a.c = (const float*)d_in[1]; a.ctx = (const float*)d_in[2]; a.cctx = (const float*)d_in[3];
    a.wmod = (const float*)d_in[4]; a.bmod = (const float*)d_in[5]; a.normg = (const float*)d_in[6]; a.win = (const float*)d_in[7];
    a.qg = (const float*)d_in[8]; a.kg = (const float*)d_in[9]; a.convw = (const float*)d_in[10]; a.wout = (const float*)d_in[11]; a.fg = (const float*)d_in[12];
    a.out = (float*)d_out; a.ws = (unsigned char*)d_ws; a.use_cg = 0; a.pad = 0;
    if (hipMemsetAsync((char*)d_ws + WS_BAR, 0, CTL_BYTES, stream) != hipSuccess) { fprintf(stderr, "kernel_launch: hipMemsetAsync failed\n"); return; }
    void* args[] = {&a};
    hipError_t e = hipLaunchCooperativeKernel((const void*)fwd_megakernel, dim3(grid_blocks), dim3(NTHREADS), args, LDS_BYTES, stream);
    if (e != hipSuccess) fprintf(stderr, "cooperative launch failed: %s (grid %d)\n", hipGetErrorString(e), grid_blocks);
}
```

```cpp
#include <hip/hip_runtime.h>
#include <hip/hip_cooperative_groups.h>
#include <cstdio>
#include <cstdint>
namespace cg = cooperative_groups;

#define LAS __attribute__((address_space(3)))
typedef unsigned short bf16_t;
typedef short bf16x8 __attribute__((ext_vector_type(8)));
typedef short s16x4 __attribute__((ext_vector_type(4)));
typedef float f32x2 __attribute__((ext_vector_type(2)));
typedef float f32x4 __attribute__((ext_vector_type(4)));
typedef float f32x16 __attribute__((ext_vector_type(16)));
typedef unsigned u32x2 __attribute__((ext_vector_type(2)));
typedef unsigned u32x4 __attribute__((ext_vector_type(4)));

constexpr int DM = 2048, NB = 2, SEQ = 4096, CTX = 256, MLAT = NB * SEQ, MCTX = NB * CTX, MALL = MLAT + MCTX;
constexpr int NIN = 6656, HD = 128, NH = 8, NKV = 2, SKV = CTX + SEQ, AW = 1024, CW = 1024;
constexpr float EPS = 1e-6f;
constexpr float QSCALE_F = 0.088388347648318440f * 1.4426950408889634f;
constexpr int NWAVES = 8, NTHREADS = 512;

constexpr size_t MiB = 1u << 20;
constexpr size_t WS_PART = 0;
constexpr size_t WS_BAR  = 768 * 1024;
constexpr int PANEL_CNT_WORD = 4096, TT_QUEUE_WORD = 7168; constexpr size_t CTL_BYTES = 32768;
constexpr size_t WS_GATE = 1 * MiB;
constexpr size_t WS_SSQ  = 2 * MiB;
constexpr size_t WS_WIN  = 4 * MiB;
constexpr size_t WS_WOUT = 30 * MiB;
constexpr size_t WS_H    = 38 * MiB;
constexpr size_t WS_Q    = 72 * MiB;
constexpr size_t WS_K    = 88 * MiB;
constexpr size_t WS_V    = 93 * MiB;
constexpr size_t WS_GA   = 98 * MiB;
constexpr size_t WS_U    = 114 * MiB;
constexpr size_t WS_G    = 130 * MiB;
constexpr size_t WS_MIX  = 146 * MiB;
constexpr size_t WS_END  = 178 * MiB;

constexpr int RING_BYTES = 131072, XCH_OFF = RING_BYTES, MISC_OFF = XCH_OFF + 12288, LDS_BYTES = 147456;

__device__ __forceinline__ unsigned cvt_pk_bf16(float lo, float hi) { unsigned r; asm volatile("v_cvt_pk_bf16_f32 %0, %1, %2" : "=v"(r) : "v"(lo), "v"(hi)); return r; }
__device__ __forceinline__ float bf2f(unsigned short h) { return __builtin_bit_cast(float, (unsigned)h << 16); }
__device__ __forceinline__ float bflo(unsigned w) { return __builtin_bit_cast(float, w << 16); }
__device__ __forceinline__ float bfhi(unsigned w) { return __builtin_bit_cast(float, w & 0xffff0000u); }
__device__ __forceinline__ float silu_f(float x) { return x * __builtin_amdgcn_rcpf(1.f + __builtin_amdgcn_exp2f(-1.4426950408889634f * x)); }
__device__ __forceinline__ void silu2(float a, float b, float& sa, float& sb) {
    const float pa = 1.f + __builtin_amdgcn_exp2f(-1.4426950408889634f * a), pb = 1.f + __builtin_amdgcn_exp2f(-1.4426950408889634f * b);
    const float r = __builtin_amdgcn_rcpf(pa * pb); sa = a * (r * pb); sb = b * (r * pa); }
__device__ __forceinline__ float silu_acc(float x) { return x * __builtin_amdgcn_rcpf(1.f + __builtin_amdgcn_exp2f(-1.4426950408889634f * x)); }
__device__ __forceinline__ float wave_sum(float v) {
#pragma unroll
    for (int o = 1; o < 64; o <<= 1) v += __shfl_xor(v, o);
    return v;
}
__device__ __forceinline__ int opaque_tid(int wave_s) { int l = __builtin_amdgcn_mbcnt_hi(~0u, __builtin_amdgcn_mbcnt_lo(~0u, 0u)); asm volatile("" : "+v"(l)); return wave_s * 64 + l; }
template <int N> __device__ __forceinline__ float row_ror(float v) { return __builtin_bit_cast(float, __builtin_amdgcn_update_dpp(0, __builtin_bit_cast(int, v), 0x120 + N, 0xf, 0xf, false)); }
#define LDS_WAIT() asm volatile("s_waitcnt lgkmcnt(0)" ::: "memory")

namespace pg8 {
constexpr int BM = 256, BK = 64, HALF = 128, HTB = HALF * BK * 2, STAGE_BYTES = 8 * HTB, NXCD = 8, WGM = 8;
__host__ __device__ __forceinline__ int lds_byte(int r, int c) { const int st = (r >> 4) * 2 + (c >> 5), rr = r & 15, cc = c & 31, ob = rr * 64 + cc * 2; return st * 1024 + (ob ^ (((ob >> 9) & 1) << 5)); }
__host__ __device__ __forceinline__ void stage_rc(int b, int& R, int& C) { const int st = b / 1024, sb = b % 1024, swz = sb ^ (((sb >> 9) & 1) << 5); R = (st >> 1) * 16 + swz / 64; C = (st & 1) * 32 + (swz % 64) / 2; }
__host__ __device__ __forceinline__ int perm32(int rho) { const int n = rho >> 4, i = rho & 15; return 8 * (i >> 2) + 4 * n + (i & 3); }

struct Unit { int pm, pn; };
struct Gemm { const bf16_t* A; const bf16_t* Bt; int M, N, K; };

template <int NM, int NN, int EXTRA = 0, int EPM0 = 0, int EPN0 = 0, int ENN = 1>
struct TileMap {
    static constexpr int nwg = NM * NN, ntot = nwg + EXTRA;
    __device__ static __forceinline__ void decode(int ui, Unit& u) {
        if (EXTRA > 0 && ui >= nwg) { const int j = ui - nwg; u.pm = EPM0 + j / ENN; u.pn = EPN0 + j % ENN; return; }
        int wgid = ui; { constexpr int q = nwg / NXCD, r = nwg % NXCD; const int xcd = wgid % NXCD, off = wgid / NXCD; wgid = (xcd < r ? xcd * (q + 1) : r * (q + 1) + (xcd - r) * q) + off; }
        constexpr int nig = WGM * NN; const int gid = wgid / nig, fm = gid * WGM, gsz = (NM - fm) < WGM ? (NM - fm) : WGM;
        u.pm = fm + ((wgid % nig) % gsz); u.pn = (wgid % nig) / gsz;
    }
};
template <class Map> struct StaticOrder {
    int G, c, limit;
    __device__ __forceinline__ void init(int G_, int c_, int limit_) { G = G_; c = c_; limit = limit_; }
    __device__ __forceinline__ bool next(int i, Unit& u) const { const int L = i * G + c; if (L >= limit) return false; Map::decode(L, u); return true; }
};
template <class Map> struct OneUnit {
    int ui;
    __device__ __forceinline__ bool next(int i, Unit& u) const { if (i != 0 || ui < 0) return false; Map::decode(ui, u); return true; }
};

template <class Epi, class Sched, int RH = -1, bool PROLOGUE = true, bool DRAIN = true>
__device__ __forceinline__ void gemm_phase(LAS unsigned char* lds, const Gemm g, const Sched& S, const Epi& E, int wave_s, const Unit* handoff = nullptr) {
    const int tid = opaque_tid(wave_s), wid = wave_s, lane = tid & 63, wr = wid >> 2, wc = wid & 3, fr = lane & 15, fq = lane >> 4;
    const int K = g.K, nt = K / BK;
    unsigned voffA[2], voffB[2];
#pragma unroll
    for (int i = 0; i < 2; ++i) { int R, C; stage_rc(tid * 16 + i * 8192, R, C); const int Rb = (R & ~31) + perm32(R & 31);
        voffA[i] = (unsigned)(R * K + C) * 2u; voffB[i] = (unsigned)(Rb * K + C) * 2u; }
    const size_t kstep = (size_t)(BK * 2);
    const size_t hstep = (size_t)HALF * K * 2;
    const size_t tstep = 2 * hstep;
    const unsigned ldsw = (unsigned)wid * 1024u;
    const int aoff = lds_byte(wr * 64 + fr, fq * 8), boff = lds_byte(wc * 32 + fr, fq * 8);
#define PG8_SA(b, h) (((b) * 2 + (h)) * HTB)
#define PG8_SB(b, h) ((4 + (b) * 2 + (h)) * HTB)
#define PG8_STAGE(bufoff, gbase, voff) do { _Pragma("unroll") for (int _i = 0; _i < 2; ++_i) \
        __builtin_amdgcn_global_load_lds((const unsigned*)((const char*)(gbase) + (voff)[_i]), (LAS unsigned*)(lds + (bufoff) + ldsw + _i * 8192), 16, 0, 0); } while (0)
#define PG8_LDA(dst, b, h) do { _Pragma("unroll") for (int m = 0; m < 4; ++m) _Pragma("unroll") for (int k = 0; k < 2; ++k) dst[m][k] = *(const LAS bf16x8*)(lds + PG8_SA(b, h) + aoff + m * 2048 + k * 1024); } while (0)
#define PG8_LDB(dst, b, h) do { _Pragma("unroll") for (int n = 0; n < 2; ++n) _Pragma("unroll") for (int k = 0; k < 2; ++k) dst[n][k] = *(const LAS bf16x8*)(lds + PG8_SB(b, h) + boff + n * 2048 + k * 1024); } while (0)
#define PG8_MMA(ai, bj, At, Bt) do { __builtin_amdgcn_s_setprio(1); _Pragma("unroll") for (int m = 0; m < 4; ++m) _Pragma("unroll") for (int n = 0; n < 2; ++n) _Pragma("unroll") for (int k = 0; k < 2; ++k) \
        acc[ai][bj][m][n] = __builtin_amdgcn_mfma_f32_16x16x32_bf16(Bt[n][k], At[m][k], acc[ai][bj][m][n], 0, 0, 0); __builtin_amdgcn_s_setprio(0); } while (0)
#define PG8_WAIT_V(n) asm volatile("s_waitcnt vmcnt(" #n ")" ::: "memory")
#define PG8_WAIT_L(n) asm volatile("s_waitcnt lgkmcnt(" #n ")" ::: "memory")
#define PG8_BAR __builtin_amdgcn_s_barrier()
#define PG8_SCHED __builtin_amdgcn_sched_barrier(0)
    Unit cur, nxt; int ui = 0;
    if (!S.next(0, cur)) return;
    f32x4 acc[2][2][4][2];
#pragma unroll
    for (int a = 0; a < 2; ++a)
#pragma unroll
        for (int b = 0; b < 2; ++b)
#pragma unroll
            for (int m = 0; m < 4; ++m)
#pragma unroll
                for (int n = 0; n < 2; ++n) acc[a][b][m][n] = (f32x4){0.f, 0.f, 0.f, 0.f};
    bf16x8 At[4][2], B0[2][2], B1[2][2];
    const char* cA = (const char*)g.A + (size_t)cur.pm * tstep; const char* cB = (const char*)g.Bt + (size_t)cur.pn * tstep;
    if constexpr (PROLOGUE) {
    PG8_STAGE(PG8_SB(0, 0), cB, voffB); PG8_STAGE(PG8_SB(0, 1), cB + hstep, voffB); PG8_STAGE(PG8_SA(0, 0), cA, voffA); PG8_STAGE(PG8_SA(0, 1), cA + hstep, voffA);
    if (wr == 1) PG8_BAR;
    PG8_WAIT_V(2); PG8_BAR;
    PG8_STAGE(PG8_SB(1, 0), cB + kstep, voffB); PG8_STAGE(PG8_SA(1, 0), cA + kstep, voffA); PG8_STAGE(PG8_SB(1, 1), cB + hstep + kstep, voffB);
    PG8_WAIT_V(6); PG8_BAR;
    }
    for (;;) {
        const bool has_next = S.next(ui + 1, nxt);
        constexpr bool do0 = RH != 1, do1 = RH != 0;
        const bool chain = !has_next && !DRAIN && handoff != nullptr;
        const Unit pre = chain ? *handoff : nxt; const bool has_pref = has_next || chain;
        const char* nA = has_pref ? (const char*)g.A + (size_t)pre.pm * tstep : cA; const char* nB = has_pref ? (const char*)g.Bt + (size_t)pre.pn * tstep : cB;
        for (int t = 0; t < nt; t += 2) {
            const bool last = (t == nt - 2);
            const char* a1 = cA + (size_t)(t + 1) * kstep;
            const char* a2 = last ? nA : cA + (size_t)(t + 2) * kstep; const char* b2 = last ? nB : cB + (size_t)(t + 2) * kstep;
            const char* a3 = a2 + kstep; const char* b3 = b2 + kstep;
            PG8_LDB(B0, 0, 0); PG8_LDB(B1, 0, 1); PG8_SCHED; if (do0) PG8_LDA(At, 0, 0); PG8_STAGE(PG8_SA(1, 1), a1 + hstep, voffA);
            PG8_WAIT_V(8); PG8_WAIT_L(0); PG8_BAR; if (do0) { PG8_MMA(0, 0, At, B0); PG8_MMA(0, 1, At, B1); } PG8_BAR; PG8_SCHED;
            if (do1) PG8_LDA(At, 0, 1); PG8_STAGE(PG8_SB(0, 0), b2, voffB); PG8_STAGE(PG8_SB(0, 1), b2 + hstep, voffB); PG8_STAGE(PG8_SA(0, 0), a2, voffA);
            PG8_WAIT_V(8); PG8_WAIT_L(0); PG8_BAR; if (do1) { PG8_MMA(1, 0, At, B0); PG8_MMA(1, 1, At, B1); } PG8_BAR; PG8_SCHED;
            PG8_LDB(B0, 1, 0); PG8_LDB(B1, 1, 1); PG8_SCHED; if (do0) PG8_LDA(At, 1, 0); PG8_STAGE(PG8_SA(0, 1), a2 + hstep, voffA);
            PG8_WAIT_V(8); PG8_WAIT_L(0); PG8_BAR; if (do0) { PG8_MMA(0, 0, At, B0); PG8_MMA(0, 1, At, B1); } PG8_BAR; PG8_SCHED;
            if (do1) PG8_LDA(At, 1, 1); PG8_STAGE(PG8_SB(1, 0), b3, voffB); PG8_STAGE(PG8_SB(1, 1), b3 + hstep, voffB); PG8_STAGE(PG8_SA(1, 0), a3, voffA);
            PG8_WAIT_V(8); PG8_WAIT_L(0); PG8_BAR; if (do1) { PG8_MMA(1, 0, At, B0); PG8_MMA(1, 1, At, B1); } PG8_BAR; PG8_SCHED;
        }
        if (wr == 0) PG8_BAR;
        E.template run<RH>(acc, cur, wr, wc, fr, fq);
        if (!has_next) break;
#pragma unroll
        for (int a = 0; a < 2; ++a)
#pragma unroll
            for (int b = 0; b < 2; ++b)
#pragma unroll
                for (int m = 0; m < 4; ++m)
#pragma unroll
                    for (int n = 0; n < 2; ++n) acc[a][b][m][n] = (f32x4){0.f, 0.f, 0.f, 0.f};
        cur = nxt; cA = nA; cB = nB; ++ui;
        if (wr == 1) PG8_BAR;
    }
    if constexpr (DRAIN) { PG8_WAIT_V(0); PG8_BAR; }
    else { if (handoff != nullptr) { if (wr == 1) PG8_BAR; } else { PG8_WAIT_V(0); PG8_BAR; } }
#undef PG8_SA
#undef PG8_SB
#undef PG8_STAGE
#undef PG8_LDA
#undef PG8_LDB
#undef PG8_MMA
#undef PG8_WAIT_V
#undef PG8_WAIT_L
#undef PG8_BAR
#undef PG8_SCHED
}
}

__host__ __device__ __forceinline__ int win_src_col(int n) {
    if (n < 1280) { const int hb = n & ~127, s = n & 127, p = s >> 1, e = s & 1; return hb + (p < 32 ? p : p + 32) + 32 * e; }
    if (n < 2560) return n;
    const int t = n - 2560, ct = t >> 8, w = t & 255, half = w >> 7, s = w & 127, ch = ct * 64 + (s >> 1), e = s & 1;
    const int sec = half == 0 ? (e == 0 ? 3584 : 4608) : (e == 0 ? 2560 : 5632);
    return sec + ch;
}
struct EpiIn {
    unsigned char* ws; const float *qg, *kg, *convw; LAS float* P;
    template <int RH> __device__ __forceinline__ void run(f32x4 (&acc)[2][2][4][2], const pg8::Unit& u, int wr, int wc, int fr, int fq) const {
        asm volatile("" : "+v"(fr), "+v"(fq));
        const int pn = u.pn, pm = u.pm;
        bf16_t* const Q = (bf16_t*)(ws + WS_Q); bf16_t* const KB = (bf16_t*)(ws + WS_K); bf16_t* const VB = (bf16_t*)(ws + WS_V);
        bf16_t* const GA = (bf16_t*)(ws + WS_GA); bf16_t* const U = (bf16_t*)(ws + WS_U); bf16_t* const G = (bf16_t*)(ws + WS_G);
        const int rl0 = wr * 64 + fr;
        const bool isctx = pm >= 32;
        const int kvrow0 = isctx ? (pm - 32) * SKV : (pm >> 4) * SKV + CTX + (pm & 15) * 256;
        if (pn <= 4) {
            const bool isk = (pn == 4);
            const float* gw = isk ? kg : qg;
            float g1[2][2], g2[2][2], invf[2][2];
#pragma unroll
            for (int n = 0; n < 2; ++n)
#pragma unroll
                for (int jj = 0; jj < 2; ++jj) { const int p = 16 * wc + 4 * fq + 2 * n + jj, d1 = p < 32 ? p : p + 32;
                    g1[n][jj] = gw[d1]; g2[n][jj] = gw[d1 + 32]; invf[n][jj] = exp2f(-(float)(p & 31) * 0.41524101186092029f) * 0.15915494309189535f; }
#pragma unroll
            for (int ai = 0; ai < 2; ++ai) if (RH < 0 || ai == RH)
#pragma unroll
                for (int m = 0; m < 4; ++m)
#pragma unroll
                    for (int bj = 0; bj < 2; ++bj) { const f32x4 a = acc[ai][bj][m][0], b = acc[ai][bj][m][1];
                        float s = (a[0] * a[0] + a[1] * a[1]) + (a[2] * a[2] + a[3] * a[3]) + (b[0] * b[0] + b[1] * b[1]) + (b[2] * b[2] + b[3] * b[3]);
                        s += __shfl_xor(s, 16); s += __shfl_xor(s, 32);
                        if (fq == 0) P[((ai * 128 + rl0 + 16 * m) * 2 + bj) * 4 + wc] = s; }
            LDS_WAIT(); __builtin_amdgcn_s_barrier();
            bf16_t* obase; int ld;
            if (isk) { obase = KB + (size_t)kvrow0 * 256; ld = 256; } else { obase = Q + (size_t)pm * 256 * 1024 + pn * 256; ld = 1024; }
#pragma unroll
            for (int ai = 0; ai < 2; ++ai) if (RH < 0 || ai == RH)
#pragma unroll
                for (int m = 0; m < 4; ++m) { const int rl = ai * 128 + rl0 + 16 * m; const int t = (pm & 15) * 256 + rl;
                    const float pos = (float)(wc < 2 ? (t >> 6) : (t & 63));
                    float cs[2][2], sn[2][2];
#pragma unroll
                    for (int n = 0; n < 2; ++n)
#pragma unroll
                        for (int jj = 0; jj < 2; ++jj) { float rev = pos * invf[n][jj]; rev -= floorf(rev);
                            cs[n][jj] = isctx ? 1.f : __builtin_amdgcn_cosf(rev); sn[n][jj] = isctx ? 0.f : __builtin_amdgcn_sinf(rev); }
#pragma unroll
                    for (int bj = 0; bj < 2; ++bj) { const f32x4 pp = *(const LAS f32x4*)(P + (rl * 2 + bj) * 4);
                        const float rstd = rsqrtf(((pp[0] + pp[1]) + (pp[2] + pp[3])) * (1.f / 128.f) + EPS) * (isk ? 1.f : QSCALE_F);
                        unsigned w[4];
#pragma unroll
                        for (int n = 0; n < 2; ++n)
#pragma unroll
                            for (int jj = 0; jj < 2; ++jj) { const float x1 = acc[ai][bj][m][n][2 * jj] * rstd * g1[n][jj], x2 = acc[ai][bj][m][n][2 * jj + 1] * rstd * g2[n][jj];
                                w[2 * n + jj] = cvt_pk_bf16(x1 * cs[n][jj] - x2 * sn[n][jj], x2 * cs[n][jj] + x1 * sn[n][jj]); }
                        *(u32x4*)(obase + (size_t)rl * ld + bj * 128 + 32 * wc + 8 * fq) = (u32x4){w[0], w[1], w[2], w[3]}; } }
        } else if (pn == 5) {
#pragma unroll
            for (int ai = 0; ai < 2; ++ai) if (RH < 0 || ai == RH)
#pragma unroll
                for (int m = 0; m < 4; ++m) { const int rl = ai * 128 + rl0 + 16 * m;
#pragma unroll
                    for (int bj = 0; bj < 2; ++bj) { const f32x4 a = acc[ai][bj][m][0], b = acc[ai][bj][m][1];
                        *(u32x4*)(VB + (size_t)(kvrow0 + rl) * 256 + bj * 128 + 32 * wc + 8 * fq) = (u32x4){cvt_pk_bf16(a[0], a[1]), cvt_pk_bf16(a[2], a[3]), cvt_pk_bf16(b[0], b[1]), cvt_pk_bf16(b[2], b[3])}; } }
        } else if (pn < 10) {
#pragma unroll
            for (int ai = 0; ai < 2; ++ai) if (RH < 0 || ai == RH)
#pragma unroll
                for (int m = 0; m < 4; ++m) { const int rl = ai * 128 + rl0 + 16 * m;
#pragma unroll
                    for (int bj = 0; bj < 2; ++bj) { const f32x4 a = acc[ai][bj][m][0], b = acc[ai][bj][m][1];
                        float s0, s1, s2, s3, s4, s5, s6, s7; silu2(a[0], a[1], s0, s1); silu2(a[2], a[3], s2, s3); silu2(b[0], b[1], s4, s5); silu2(b[2], b[3], s6, s7);
                        *(u32x4*)(GA + (size_t)(pm * 256 + rl) * 1024 + (pn - 6) * 256 + bj * 128 + 32 * wc + 8 * fq) =
                            (u32x4){cvt_pk_bf16(s0, s1), cvt_pk_bf16(s2, s3), cvt_pk_bf16(s4, s5), cvt_pk_bf16(s6, s7)}; } }
        } else {
            const int cl = 16 * wc + 4 * fq, ch0 = (pn - 10) * 64 + cl;
            bf16_t* const MIXp = (bf16_t*)(ws + WS_MIX);
            float cw0[4], cw1[4], cw2[4];
#pragma unroll
            for (int q = 0; q < 4; ++q) { cw0[q] = convw[ch0 + q]; cw1[q] = convw[CW + ch0 + q]; cw2[q] = convw[2 * CW + ch0 + q]; }
            LAS float* E = P + 2048;
#pragma unroll
            for (int ai = 0; ai < 2; ++ai) if (RH < 0 || ai == RH) {
#pragma unroll
                for (int q = 0; q < 4; ++q) { const f32x4 cf = acc[ai][0][0][q >> 1], cl4 = acc[ai][0][3][q >> 1];
                    if (fr == 0)  E[((ai * 2 + wr) * 2 + 0) * 64 + cl + q] = cf[2 * (q & 1)] * cf[2 * (q & 1) + 1];
                    if (fr == 15) E[((ai * 2 + wr) * 2 + 1) * 64 + cl + q] = cl4[2 * (q & 1)] * cl4[2 * (q & 1) + 1]; } }
            LDS_WAIT(); __builtin_amdgcn_s_barrier(); asm volatile("" ::: "memory");
#pragma unroll
            for (int ai = 0; ai < 2; ++ai) if (RH < 0 || ai == RH) {
                float u[4][4], g[4][4];
#pragma unroll
                for (int m = 0; m < 4; ++m)
#pragma unroll
                    for (int q = 0; q < 4; ++q) { const f32x4 c = acc[ai][0][m][q >> 1], d = acc[ai][1][m][q >> 1];
                        u[m][q] = c[2 * (q & 1)] * c[2 * (q & 1) + 1]; g[m][q] = d[2 * (q & 1)] * silu_f(d[2 * (q & 1) + 1]); }
                float eprev[4], enext[4];
#pragma unroll
                for (int q = 0; q < 4; ++q) { eprev[q] = E[((ai * 2 + 0) * 2 + 1) * 64 + cl + q]; enext[q] = E[((ai * 2 + 1) * 2 + 0) * 64 + cl + q]; }
#pragma unroll
                for (int m = 0; m < 4; ++m) { const int rl = 64 * wr + 16 * m + fr;
                    const size_t row = (size_t)pm * 256 + ai * 128 + rl;
                    float o[4];
#pragma unroll
                    for (int q = 0; q < 4; ++q) {
                        const float sp = row_ror<1>(u[m][q]), spb = (m > 0) ? row_ror<1>(u[m > 0 ? m - 1 : 0][q]) : eprev[q];
                        const float sn = row_ror<15>(u[m][q]), snb = (m < 3) ? row_ror<15>(u[m < 3 ? m + 1 : 3][q]) : enext[q];
                        const float pv = (fr == 0) ? spb : sp, nx = (fr == 15) ? snb : sn;
                        o[q] = g[m][q] * (cw0[q] * pv + cw1[q] * u[m][q] + cw2[q] * nx); }
                    if (rl != 0 && rl != 127) *(u32x2*)(MIXp + row * DM + AW + ch0) = (u32x2){cvt_pk_bf16(o[0], o[1]), cvt_pk_bf16(o[2], o[3])};
                    if (rl <= 1 || rl >= 126) *(u32x2*)(U + row * CW + ch0) = (u32x2){cvt_pk_bf16(u[m][0], u[m][1]), cvt_pk_bf16(u[m][2], u[m][3])};
                    if (rl == 0 || rl == 127) *(u32x2*)(G + row * CW + ch0) = (u32x2){cvt_pk_bf16(g[m][0], g[m][1]), cvt_pk_bf16(g[m][2], g[m][3])}; }
            }
        }
    }
};

__device__ __forceinline__ unsigned xch_ld(unsigned* p)              { return __hip_atomic_load(p, __ATOMIC_RELAXED, __HIP_MEMORY_SCOPE_AGENT); }
__device__ __forceinline__ unsigned xch_add(unsigned* p, unsigned v) { return __hip_atomic_fetch_add(p, v, __ATOMIC_RELAXED, __HIP_MEMORY_SCOPE_AGENT); }
struct EpiOut {
    const float* x; const float* fg; float* out; unsigned char* ws;
    template <int RH> __device__ __forceinline__ void run(f32x4 (&acc)[2][2][4][2], const pg8::Unit& u, int wr, int wc, int fr, int fq) const {
        static_assert(RH < 0, "whole tiles only");
        const int pm = u.pm, pn = u.pn, b = pm >> 4;
        const float* const gate = (const float*)(ws + WS_GATE); float* const ssq = (float*)(ws + WS_SSQ); unsigned* const cnt = (unsigned*)(ws + WS_BAR) + PANEL_CNT_WORD;
        const int col0 = pn * 256 + 32 * wc + 8 * fq;
        {
            f32x4 gt[2][2];
#pragma unroll
            for (int bj = 0; bj < 2; ++bj)
#pragma unroll
                for (int n = 0; n < 2; ++n) gt[bj][n] = *(const f32x4*)(gate + b * DM + col0 + bj * 128 + 4 * n);
#pragma unroll
            for (int ai = 0; ai < 2; ++ai)
#pragma unroll
                for (int m = 0; m < 4; ++m) { const int row = pm * 256 + ai * 128 + wr * 64 + 16 * m + fr; float ss = 0.f;
#pragma unroll
                    for (int bj = 0; bj < 2; ++bj)
#pragma unroll
                        for (int n = 0; n < 2; ++n) { const f32x4 xv = *(const f32x4*)(x + (size_t)row * DM + col0 + bj * 128 + 4 * n); const f32x4 y = xv + gt[bj][n] * acc[ai][bj][m][n];
                            acc[ai][bj][m][n] = y; ss += (y[0] * y[0] + y[1] * y[1]) + (y[2] * y[2] + y[3] * y[3]); }
                    ss += __shfl_xor(ss, 16); ss += __shfl_xor(ss, 32);
                    if (fq == 0) __hip_atomic_store((unsigned*)ssq + (size_t)row * 32 + pn * 4 + wc, __float_as_uint(ss), __ATOMIC_RELAXED, __HIP_MEMORY_SCOPE_AGENT); }
        }
        asm volatile("s_waitcnt vmcnt(0)" ::: "memory");
        __syncthreads();
        if (wr == 0 && wc == 0 && fr == 0 && fq == 0) {
            unsigned* c = cnt + 64 * pm;
            (void)xch_add(c, 1u);
            unsigned sp = 0u; while (xch_ld(c) < 8u) { __builtin_amdgcn_s_sleep(1); if (++sp > (1u << 20)) break; }
        }
        __syncthreads();
        f32x4 fgv[2][2];
#pragma unroll
        for (int bj = 0; bj < 2; ++bj)
#pragma unroll
            for (int n = 0; n < 2; ++n) fgv[bj][n] = *(const f32x4*)(fg + col0 + bj * 128 + 4 * n);
#pragma unroll
        for (int ai = 0; ai < 2; ++ai)
#pragma unroll
            for (int m = 0; m < 4; ++m) { const int row = pm * 256 + ai * 128 + wr * 64 + 16 * m + fr;
                const unsigned long long* p = (const unsigned long long*)(ssq + (size_t)row * 32 + 8 * fq);
                const unsigned long long q0 = __hip_atomic_load(p, __ATOMIC_RELAXED, __HIP_MEMORY_SCOPE_AGENT), q1 = __hip_atomic_load(p + 1, __ATOMIC_RELAXED, __HIP_MEMORY_SCOPE_AGENT),
                                         q2 = __hip_atomic_load(p + 2, __ATOMIC_RELAXED, __HIP_MEMORY_SCOPE_AGENT), q3 = __hip_atomic_load(p + 3, __ATOMIC_RELAXED, __HIP_MEMORY_SCOPE_AGENT);
#define LOF(q) __uint_as_float((unsigned)(q))
#define HIF(q) __uint_as_float((unsigned)((q) >> 32))
                float s = ((LOF(q0) + HIF(q0)) + (LOF(q1) + HIF(q1))) + ((LOF(q2) + HIF(q2)) + (LOF(q3) + HIF(q3)));
#undef LOF
#undef HIF
                s += __shfl_xor(s, 16); s += __shfl_xor(s, 32);
                const float rstd = rsqrtf(s * (1.f / DM) + EPS);
#pragma unroll
                for (int bj = 0; bj < 2; ++bj)
#pragma unroll
                    for (int n = 0; n < 2; ++n) __builtin_nontemporal_store(acc[ai][bj][m][n] * rstd * fgv[bj][n], (f32x4*)(out + (size_t)row * DM + col0 + bj * 128 + 4 * n)); }
    }
};

struct ConvFixHook {
    const bf16_t* Ub; const bf16_t* Gb; const float* convw; bf16_t* MIX; int e, tid;
    __device__ __forceinline__ void operator()() const {
        if (e >= 0 && tid < 128) { const int ch0 = tid * 8, m = (e >> 1) * 128 + ((e & 1) ? 127 : 0);
            const u32x4 z = {0u, 0u, 0u, 0u};
            const u32x4 up = ((m & (SEQ - 1)) == 0) ? z : *(const u32x4*)(Ub + (size_t)(m - 1) * CW + ch0);
            const u32x4 uc = *(const u32x4*)(Ub + (size_t)m * CW + ch0);
            const u32x4 un = ((m & (SEQ - 1)) == SEQ - 1) ? z : *(const u32x4*)(Ub + (size_t)(m + 1) * CW + ch0);
            const u32x4 gg = *(const u32x4*)(Gb + (size_t)m * CW + ch0);
            unsigned o[4];
#pragma unroll
            for (int q = 0; q < 4; ++q) {
                const float w0l = convw[ch0 + 2 * q], w0h = convw[ch0 + 2 * q + 1], w1l = convw[CW + ch0 + 2 * q], w1h = convw[CW + ch0 + 2 * q + 1], w2l = convw[2 * CW + ch0 + 2 * q], w2h = convw[2 * CW + ch0 + 2 * q + 1];
                const float lo = bflo(gg[q]) * (w0l * bflo(up[q]) + w1l * bflo(uc[q]) + w2l * bflo(un[q]));
                const float hi = bfhi(gg[q]) * (w0h * bfhi(up[q]) + w1h * bfhi(uc[q]) + w2h * bfhi(un[q]));
                o[q] = cvt_pk_bf16(lo, hi); }
            *(u32x4*)(MIX + (size_t)m * DM + AW + ch0) = (u32x4){o[0], o[1], o[2], o[3]}; }
    }
};

namespace att {
constexpr int D = 128, QBLK = 32, KVBLK = 64;
constexpr float SCALE = 0.088388347648318440f, QSCALE = SCALE * 1.4426950408889634f;
constexpr int LDQ = 1024, LDK = 256;
constexpr int NBUF = 3;
constexpr size_t SHM_V = KVBLK * D * 2, SHM_K = KVBLK * D * 2, SHM_ATTN = NBUF * (SHM_V + SHM_K) + NWAVES * 64 * 4;
constexpr int OST_PITCH = 272, OST_WAVE = 32 * OST_PITCH;
constexpr size_t WS_OFF = NBUF * (SHM_V + SHM_K);
static_assert(WS_OFF >= 8 * (size_t)OST_WAVE, "O staging below the l words");
#define KSWZ(row, colB) ((row) * 256 + ((colB) ^ (((row) & 7) << 4)))
#define SBAR() __builtin_amdgcn_sched_barrier(0)
__device__ __forceinline__ int crow(int r, int hi) { return (r & 3) + 8 * (r >> 2) + 4 * hi; }
__device__ __forceinline__ void expHalf(f32x16& p) {
#pragma unroll
  for (int r = 0; r < 16; ++r) p[r] = __builtin_amdgcn_exp2f(p[r]);
}
__device__ __forceinline__ void finishSM(f32x16& p0, f32x16& p1, float& l_reg, bf16x8& pa0, bf16x8& pa1, bf16x8& pa2, bf16x8& pa3) {
  expHalf(p1);
  float ps = 0;
#pragma unroll
  for (int r = 0; r < 16; ++r) ps += p0[r];
#pragma unroll
  for (int r = 0; r < 16; ++r) ps += p1[r];
  { auto rr = __builtin_amdgcn_permlane32_swap(__float_as_uint(ps), __float_as_uint(ps), false, false);
    ps = __uint_as_float(rr[0]) + __uint_as_float(rr[1]); }
  l_reg += ps;
#define PK4(P, BASE, OUT) do { unsigned a0 = cvt_pk_bf16(P[BASE + 0], P[BASE + 1]), a1 = cvt_pk_bf16(P[BASE + 2], P[BASE + 3]);   \
    unsigned b0 = cvt_pk_bf16(P[BASE + 4], P[BASE + 5]), b1 = cvt_pk_bf16(P[BASE + 6], P[BASE + 7]);                              \
    auto r0 = __builtin_amdgcn_permlane32_swap(a0, b0, false, false); auto r1 = __builtin_amdgcn_permlane32_swap(a1, b1, false, false); \
    u32x4 w = {r0[0], r1[0], r0[1], r1[1]}; OUT = *reinterpret_cast<bf16x8*>(&w); } while (0)
  PK4(p0, 0, pa0); PK4(p0, 8, pa1); PK4(p1, 0, pa2); PK4(p1, 8, pa3);
#undef PK4
}
__device__ __forceinline__ void qkt(f32x16& p0, f32x16& p1, const char* Ks, const bf16x8* qr, int r32, int hi, float init) {
#pragma unroll
  for (int r = 0; r < 16; ++r) { p0[r] = init; p1[r] = init; }
#define KLD(d0, half) (*reinterpret_cast<const bf16x8*>(Ks + KSWZ((half) * 32 + r32, ((d0) * 16 + hi * 8) * 2)))
  bf16x8 a0 = KLD(0, 0), a1 = KLD(0, 1);
  __builtin_amdgcn_s_setprio(1);
#pragma unroll
  for (int d0 = 0; d0 < 8; ++d0) {
    bf16x8 n0 = a0, n1 = a1;
    if (d0 < 7) { n0 = KLD(d0 + 1, 0); n1 = KLD(d0 + 1, 1); }
    p0 = __builtin_amdgcn_mfma_f32_32x32x16_bf16(a0, qr[d0], p0, 0, 0, 0);
    p1 = __builtin_amdgcn_mfma_f32_32x32x16_bf16(a1, qr[d0], p1, 0, 0, 0);
    a0 = n0; a1 = n1; }
  __builtin_amdgcn_s_setprio(0);
#undef KLD
}
__device__ __forceinline__ int v_st(int k, int c) { const int kk = (k & ~0xC) | ((k & 4) << 1) | ((k & 8) >> 1); return ((kk >> 3) * 4 + (c >> 5)) * 512 + ((kk & 7) * 32 + (c & 31)) * 2; }
__device__ __forceinline__ int v_rd_base(int lane) { return ((lane & 3) << 3) | (((lane >> 2) & 3) << 6) | (((lane >> 4) & 1) << 5) | (((lane >> 5) & 1) << 8); }
constexpr int v_rd_off(int d0, int ks, int half) { return d0 * 512 + ks * 4096 + half * 2048; }
template <int OFF> __device__ __forceinline__ s16x4 tr_read(int vb) {
  s16x4 r; asm volatile("ds_read_b64_tr_b16 %0, %1 offset:%2" : "=&v"(r) : "v"(vb), "i"(OFF) : "memory"); return r;
}
struct VFrag { s16x4 l0, h0, l1, h1, l2, h2, l3, h3; };
template <int D0> __device__ __forceinline__ void pv_rd(VFrag& f, int vb) {
  f.l0 = tr_read<v_rd_off(D0, 0, 0)>(vb); f.h0 = tr_read<v_rd_off(D0, 0, 1)>(vb); f.l1 = tr_read<v_rd_off(D0, 1, 0)>(vb); f.h1 = tr_read<v_rd_off(D0, 1, 1)>(vb);
  f.l2 = tr_read<v_rd_off(D0, 2, 0)>(vb); f.h2 = tr_read<v_rd_off(D0, 2, 1)>(vb); f.l3 = tr_read<v_rd_off(D0, 3, 0)>(vb); f.h3 = tr_read<v_rd_off(D0, 3, 1)>(vb);
}
__device__ __forceinline__ void pv_mm(f32x16& od, const VFrag& f, bf16x8 pa0, bf16x8 pa1, bf16x8 pa2, bf16x8 pa3) {
#define PK(L, H) (bf16x8){L[0], L[1], L[2], L[3], H[0], H[1], H[2], H[3]}
  __builtin_amdgcn_s_setprio(1);
  od = __builtin_amdgcn_mfma_f32_32x32x16_bf16(pa0, PK(f.l0, f.h0), od, 0, 0, 0);
  od = __builtin_amdgcn_mfma_f32_32x32x16_bf16(pa1, PK(f.l1, f.h1), od, 0, 0, 0);
  od = __builtin_amdgcn_mfma_f32_32x32x16_bf16(pa2, PK(f.l2, f.h2), od, 0, 0, 0);
  od = __builtin_amdgcn_mfma_f32_32x32x16_bf16(pa3, PK(f.l3, f.h3), od, 0, 0, 0);
  __builtin_amdgcn_s_setprio(0);
#undef PK
}
__device__ __forceinline__ void pv_d0(f32x16* o, int vb, bf16x8 pa0, bf16x8 pa1, bf16x8 pa2, bf16x8 pa3) {
  VFrag fa, fb;
  pv_rd<0>(fa, vb); pv_rd<1>(fb, vb);
  asm volatile("s_waitcnt lgkmcnt(8)" ::: "memory"); SBAR(); pv_mm(o[0], fa, pa0, pa1, pa2, pa3); SBAR();
  pv_rd<2>(fa, vb);
  asm volatile("s_waitcnt lgkmcnt(8)" ::: "memory"); SBAR(); pv_mm(o[1], fb, pa0, pa1, pa2, pa3); SBAR();
  pv_rd<3>(fb, vb);
  asm volatile("s_waitcnt lgkmcnt(8)" ::: "memory"); SBAR(); pv_mm(o[2], fa, pa0, pa1, pa2, pa3); SBAR();
  asm volatile("s_waitcnt lgkmcnt(0)" ::: "memory"); SBAR(); pv_mm(o[3], fb, pa0, pa1, pa2, pa3);
}
template <class Hook>
__device__ __forceinline__ void attn_dense_body(const bf16_t* __restrict__ Qb, const bf16_t* __restrict__ Kh, const bf16_t* __restrict__ Vh,
                                                const bf16_t* __restrict__ GAb, bf16_t* __restrict__ MIXb, const float* __restrict__ qg, const float* __restrict__ kg, int seq, char* lds, int wave_s, const Hook& hook) {
  const int tid = opaque_tid(wave_s), wid = wave_s, lane = tid & 63, r32 = lane & 31, hi = lane >> 5;
  char* V_lds = lds; char* K_lds = lds + NBUF * SHM_V;
#define TO_LAS(p) ((LAS unsigned char*)(unsigned)(uintptr_t)(p))
  float* ws = (float*)(lds + WS_OFF) + wid * 64; float* li_l = ws;
  float l_reg = 0; f32x16 o[4] = {}; bf16x8 qr[8];
  const int vb0 = (int)(uintptr_t)V_lds + v_rd_base(lane);
  int koff[2], voff[2];
#pragma unroll
  for (int i = 0; i < 2; ++i) { const int p = (i * 8 + wid) * 64 + lane;
    { const int row = p >> 4, c = (p & 15) ^ (row & 7); koff[i] = row * LDK + c * 8; }
    { const int S = p >> 5, within = p & 31, kk = (S >> 2) * 8 + (within >> 2), k = (kk & ~0xC) | ((kk & 4) << 1) | ((kk & 8) >> 1), col = (S & 3) * 32 + (within & 3) * 8;
      voff[i] = k * LDK + col; } }
#define DMA_TILE(b, k0) do { _Pragma("unroll") for (int _i = 0; _i < 2; ++_i) { \
    __builtin_amdgcn_global_load_lds((const unsigned*)(Kh + (long)(k0) * LDK + koff[_i]), (LAS unsigned*)(TO_LAS(K_lds) + (b) * (int)SHM_K + (_i * 8 + wid) * 1024), 16, 0, 0); \
    __builtin_amdgcn_global_load_lds((const unsigned*)(Vh + (long)(k0) * LDK + voff[_i]), (LAS unsigned*)(TO_LAS(V_lds) + (b) * (int)SHM_V + (_i * 8 + wid) * 1024), 16, 0, 0); } } while (0)
  f32x16 pA0, pA1, pB0, pB1; bf16x8 pa0, pa1, pa2, pa3; const int NT = seq / KVBLK;
  int bc = 0, bn = 1, bw = 2;
  DMA_TILE(0, 0); DMA_TILE(1, KVBLK);
  hook();
  float init;
  { float gq = fmaxf(fabsf(qg[lane]), fabsf(qg[lane + 64])), gk = fmaxf(fabsf(kg[lane]), fabsf(kg[lane + 64]));
#pragma unroll
    for (int ofs = 1; ofs < 64; ofs <<= 1) { gq = fmaxf(gq, __shfl_xor(gq, ofs)); gk = fmaxf(gk, __shfl_xor(gk, ofs)); }
    init = -(QSCALE * 128.f * 1.02f) * gq * gk; }
  const bf16_t* Qw = Qb + (long)(wid * QBLK + r32) * LDQ + hi * 8;
#pragma unroll
  for (int d0 = 0; d0 < 8; ++d0) qr[d0] = *reinterpret_cast<const bf16x8*>(Qw + d0 * 16);
  __syncthreads();
  qkt(pA0, pA1, K_lds, qr, r32, hi, init); expHalf(pA0);
#define ROT() do { const int _t = bc; bc = bn; bn = bw; bw = _t; } while (0)
#define ITER(PC0, PC1, PN0, PN1, t) do { __syncthreads(); \
    if ((t) + 2 < NT) DMA_TILE(bw, ((t) + 2) * KVBLK); \
    SBAR(); qkt(PN0, PN1, K_lds + bn * (int)SHM_K, qr, r32, hi, init); finishSM(PC0, PC1, l_reg, pa0, pa1, pa2, pa3); SBAR(); \
    pv_d0(o, vb0 + bc * (int)SHM_V, pa0, pa1, pa2, pa3); expHalf(PN0); ROT(); } while (0)
  for (int t = 0; t + 2 < NT; t += 2) { ITER(pA0, pA1, pB0, pB1, t); ITER(pB0, pB1, pA0, pA1, t + 1); }
  ITER(pA0, pA1, pB0, pB1, NT - 2);
  finishSM(pB0, pB1, l_reg, pa0, pa1, pa2, pa3); SBAR();
  pv_d0(o, vb0 + bc * (int)SHM_V, pa0, pa1, pa2, pa3);
#undef ITER
#undef ROT
#undef DMA_TILE
  u32x4 gpre[4];
#pragma unroll
  for (int i = 0; i < 4; ++i) { const int id = i * 64 + lane, row = id >> 4, cc = id & 15; gpre[i] = *(const u32x4*)(GAb + (long)(wid * QBLK + row) * 1024 + cc * 8); }
  if (hi == 0) li_l[r32] = l_reg; asm volatile("s_waitcnt lgkmcnt(0)" ::: "memory");
  __syncthreads();
  { char* ost = lds + wid * OST_WAVE;
#pragma unroll
    for (int r = 0; r < 16; ++r) { const int orow = crow(r, hi); const float rl = __builtin_amdgcn_rcpf(li_l[orow]);
#pragma unroll
      for (int d0 = 0; d0 < 4; ++d0) *(bf16_t*)(ost + orow * OST_PITCH + (d0 * 32 + r32) * 2) = (bf16_t)(cvt_pk_bf16(o[d0][r] * rl, 0.f) & 0xffffu); }
    asm volatile("s_waitcnt lgkmcnt(0)" ::: "memory");
#pragma unroll
    for (int i = 0; i < 8; ++i) { const int id = i * 64 + lane, row = id >> 4, cc = id & 15; const long grow = wid * QBLK + row;
      const u32x4 ov = *(const u32x4*)(ost + row * OST_PITCH + cc * 16); const u32x4 gv = i < 4 ? gpre[i < 4 ? i : 0] : *(const u32x4*)(GAb + grow * 1024 + cc * 8);
      u32x4 w;
#pragma unroll
      for (int q = 0; q < 4; ++q) w[q] = cvt_pk_bf16(bflo(ov[q]) * bflo(gv[q]), bfhi(ov[q]) * bfhi(gv[q]));
      *(u32x4*)(MIXb + grow * 2048 + cc * 8) = w; }
  }
  __syncthreads();
}
#undef KSWZ
#undef SBAR
}

__device__ __forceinline__ void p0_adaln(const float* __restrict__ c, const float* __restrict__ cctx, const float* __restrict__ wmod, float* part, LAS float* red,
                                         int tid, int wave, int lane, int bid, int G) {
    for (int it = bid; it < 192; it += G) {
        const int sl = it % 24, kc = it / 24, col = sl * 256 + 4 * lane, k0 = kc * 256 + wave * 32;
        f32x4 wv[32];
#pragma unroll
        for (int i = 0; i < 32; ++i) wv[i] = __builtin_nontemporal_load((const f32x4*)(wmod + (size_t)(k0 + i) * 6144 + col));
        f32x4 a0 = {0.f, 0.f, 0.f, 0.f}, a1 = a0, a2 = a0;
#pragma unroll
        for (int i = 0; i < 32; ++i) { const int k = k0 + i; a0 += silu_acc(c[k]) * wv[i]; a1 += silu_acc(c[DM + k]) * wv[i]; a2 += silu_acc(cctx[k]) * wv[i]; }
        *(LAS f32x4*)(red + ((wave * 3 + 0) * 64 + lane) * 4) = a0; *(LAS f32x4*)(red + ((wave * 3 + 1) * 64 + lane) * 4) = a1; *(LAS f32x4*)(red + ((wave * 3 + 2) * 64 + lane) * 4) = a2;
        __syncthreads();
        if (tid < 192) { const int r = tid >> 6, l = tid & 63; f32x4 sm = {0.f, 0.f, 0.f, 0.f};
#pragma unroll
            for (int w = 0; w < 8; ++w) sm += *(const LAS f32x4*)(red + ((w * 3 + r) * 64 + l) * 4);
            *(f32x4*)(part + ((size_t)kc * 3 + r) * 6144 + sl * 256 + 4 * l) = sm; }
        __syncthreads();
    }
}
template <bool PERMUTE>
__device__ __forceinline__ void p0_transpose_item(const float* __restrict__ W, int K, int N, bf16_t* WT, LAS float* scr, int item, int lane) {
    const int nblk = N / 32, kb = item / nblk, nb = item % nblk, k0 = 64 * kb, n0 = 32 * nb;
    const int srcc = PERMUTE ? win_src_col(n0 + (lane & 31)) : n0 + (lane & 31);
    float tv[32];
#pragma unroll
    for (int i = 0; i < 32; ++i) tv[i] = __builtin_nontemporal_load(W + (size_t)(k0 + 2 * i + (lane >> 5)) * N + srcc);
#pragma unroll
    for (int i = 0; i < 32; ++i) scr[(2 * i + (lane >> 5)) * 33 + (lane & 31)] = tv[i];
    LDS_WAIT(); asm volatile("" ::: "memory");
    const int cch = lane & 7;
#pragma unroll
    for (int j = 0; j < 4; ++j) { const int n = (lane >> 3) + 8 * j; const LAS float* s = scr + (8 * cch) * 33 + n;
        u32x4 o; o.x = cvt_pk_bf16(s[0 * 33], s[1 * 33]); o.y = cvt_pk_bf16(s[2 * 33], s[3 * 33]); o.z = cvt_pk_bf16(s[4 * 33], s[5 * 33]); o.w = cvt_pk_bf16(s[6 * 33], s[7 * 33]);
        *(u32x4*)(WT + (size_t)(n0 + n) * K + k0 + 8 * cch) = o; }
    LDS_WAIT(); asm volatile("" ::: "memory");
}
template <int MODE> __host__ __device__ __forceinline__ void tt_map(int T, int j, int& src, int& dst) {
    if (MODE == 1 || (T >= 5 && T <= 9)) { src = T * 256 + j; dst = j; return; }
    if (T <= 4) { src = T * 256 + j; const int hh = j >> 7, d = j & 127; const int sl = d < 32 ? 2 * d : d < 64 ? 2 * (d - 32) + 1 : d < 96 ? 2 * (d - 32) : 2 * (d - 64) + 1; dst = hh * 128 + sl; return; }
    const int ct = T - 10, r = j >> 6, c = j & 63; const int sec = r == 0 ? 3584 : r == 1 ? 4608 : r == 2 ? 2560 : 5632; src = sec + 64 * ct + c; dst = (r >> 1) * 128 + 2 * c + (r & 1);
}
constexpr int TT_PITCH = 144;
constexpr int TT_TILE_BYTES = 256 * TT_PITCH;
template <int MODE> __device__ __forceinline__ void tt_load(const float* __restrict__ W, int N, int kb, int T, int wave, int lane, f32x4 (&v)[8]) {
    int src, dst; tt_map<MODE>(T, 4 * lane, src, dst); (void)dst;
#pragma unroll
    for (int i = 0; i < 8; ++i) v[i] = __builtin_nontemporal_load((const f32x4*)(W + (size_t)(kb * 64 + wave * 8 + i) * N + src));
}
template <int MODE> __device__ __forceinline__ void tt_to_lds(LAS unsigned char* tile, int T, int wave, int lane, const f32x4 (&v)[8]) {
#pragma unroll
    for (int c = 0; c < 4; ++c) { int src, dst; tt_map<MODE>(T, 4 * lane + c, src, dst); (void)src;
        *(LAS u32x4*)(tile + dst * TT_PITCH + 16 * wave) = (u32x4){cvt_pk_bf16(v[0][c], v[1][c]), cvt_pk_bf16(v[2][c], v[3][c]), cvt_pk_bf16(v[4][c], v[5][c]), cvt_pk_bf16(v[6][c], v[7][c])}; }
}
__device__ __forceinline__ void tt_store(const LAS unsigned char* tile, bf16_t* WT, int K, int kb, int T, int tid) {
#pragma unroll
    for (int q = 0; q < 4; ++q) { const int id = q * NTHREADS + tid, n = id >> 3, cc = id & 7;
        *(u32x4*)(WT + (size_t)(T * 256 + n) * K + kb * 64 + 8 * cc) = *(const LAS u32x4*)(tile + n * TT_PITCH + 16 * cc); }
}
template <int MODE> __device__ __forceinline__ void tt_run(const float* __restrict__ W, int K, int N, bf16_t* WT, int NT, unsigned* queue, int first, int stride,
                                                          LAS unsigned char* tile, volatile LAS unsigned* word, int tid, int wave, int lane) {
    const int ntiles = (K / 64) * NT;
    if (tid == 0) *word = queue ? atomicAdd(queue, 1u) : (unsigned)first;
    __syncthreads();
    int it = (int)*word, nstat = first;
    f32x4 v[8];
    if (it < ntiles) tt_load<MODE>(W, N, it / NT, it % NT, wave, lane, v);
    __syncthreads();
    while (it < ntiles) {
        const int kb = it / NT, T = it % NT;
        tt_to_lds<MODE>(tile, T, wave, lane, v);
        nstat += stride;
        if (tid == 0) *word = queue ? atomicAdd(queue, 1u) : (unsigned)nstat;
        __syncthreads();
        const int nx = (int)*word;
        if (nx < ntiles) tt_load<MODE>(W, N, nx / NT, nx % NT, wave, lane, v);
        tt_store(tile, WT, K, kb, T, tid);
        __syncthreads();
        it = nx;
    }
}

template <int NR>
__device__ __forceinline__ void h_rows(const float* __restrict__ x0, bf16_t* o0, const LAS float* AL, const LAS float* SL, int lane) {
    f32x4 v[NR][8]; float rstd[NR];
#pragma unroll
    for (int r = 0; r < NR; ++r)
#pragma unroll
        for (int j = 0; j < 8; ++j) v[r][j] = ((const f32x4*)(x0 + (size_t)r * DM))[lane + 64 * j];
#pragma unroll
    for (int r = 0; r < NR; ++r) { float s = 0.f;
#pragma unroll
        for (int j = 0; j < 8; ++j) s += (v[r][j][0] * v[r][j][0] + v[r][j][1] * v[r][j][1]) + (v[r][j][2] * v[r][j][2] + v[r][j][3] * v[r][j][3]);
        rstd[r] = rsqrtf(wave_sum(s) * (1.f / DM) + EPS); }
#pragma unroll
    for (int j = 0; j < 8; ++j) { const f32x4 a = *(const LAS f32x4*)(AL + 4 * lane + 256 * j), sh = *(const LAS f32x4*)(SL + 4 * lane + 256 * j);
#pragma unroll
        for (int r = 0; r < NR; ++r) { const f32x4 h = v[r][j] * rstd[r] * a + sh;
            *(u32x2*)(o0 + (size_t)r * DM + 4 * lane + 256 * j) = (u32x2){cvt_pk_bf16(h[0], h[1]), cvt_pk_bf16(h[2], h[3])}; } }
}

#define XB_TMO      128
#define XB_XCNT(j)  (256  + 64 * (j))
#define XB_XSUB(j)  (1280 + 64 * (j))
#define XB_XGEN(j)  (2304 + 64 * (j))
#define XB_TOP      3328
#define XB_TOPGEN   3392
#define XCD_BAR_WORDS 3456
#define XB_SPIN_CAP (1u << 18)
__device__ __forceinline__ unsigned xb_ld(unsigned* p)              { return __hip_atomic_load(p, __ATOMIC_RELAXED, __HIP_MEMORY_SCOPE_AGENT); }
__device__ __forceinline__ unsigned xb_add(unsigned* p, unsigned v) { return __hip_atomic_fetch_add(p, v, __ATOMIC_RELAXED, __HIP_MEMORY_SCOPE_AGENT); }
__device__ __forceinline__ unsigned xb_xcc_id() { return (unsigned)__builtin_amdgcn_s_getreg((3 << 11) | 20) & 0xFu; }
#define XB_SPIN(cond, bar) do { unsigned _sp = 0; while (cond) { __builtin_amdgcn_s_sleep(1); \
    if ((++_sp & 255u) == 0u) { if (xb_ld(&(bar)[XB_TMO])) break; if (_sp > XB_SPIN_CAP) { atomicAdd(&(bar)[XB_TMO], 1u); break; } } } } while (0)
struct XcdBarrier { unsigned* bar; unsigned x; volatile LAS unsigned* st; };
__device__ __forceinline__ XcdBarrier xcd_barrier_post(unsigned* bar, volatile LAS unsigned* st, bool leader) {
    XcdBarrier b; b.bar = bar; b.x = xb_xcc_id(); b.st = st;
    if (leader) (void)xb_add(&bar[XB_XCNT(b.x)], 1u);
    return b;
}
__device__ __forceinline__ void xcd_barrier_complete(unsigned* bar, unsigned x, unsigned& nloc, unsigned& nx) {
    const unsigned G = gridDim.x * gridDim.y * gridDim.z;
    unsigned sum, cnt, mine, sp = 0u;
    for (;;) {
        sum = 0u; cnt = 0u; mine = 0u;
#pragma unroll
        for (unsigned j = 0; j < 16; ++j) { const unsigned c = xb_ld(&bar[XB_XCNT(j)]); sum += c; cnt += (c > 0u) ? 1u : 0u; mine = (j == x) ? c : mine; }
        if (sum == G) break;
        __builtin_amdgcn_s_sleep(1);
        if ((++sp & 255u) == 0u) { if (xb_ld(&bar[XB_TMO])) break; if (sp > XB_SPIN_CAP) { atomicAdd(&bar[XB_TMO], 1u); break; } }
    }
    nloc = mine > 0u ? mine : 1u; nx = cnt > 0u ? cnt : 1u;
}
__device__ __forceinline__ void xcd_barrier(const XcdBarrier& b, bool leader) {
    asm volatile("s_waitcnt vmcnt(0)" ::: "memory");
    __syncthreads();
    if (leader) {
        unsigned* bar = b.bar;
        __builtin_amdgcn_s_waitcnt(0);
        unsigned nloc = b.st[0], nx = b.st[1];
        if (nloc == 0u) { xcd_barrier_complete(bar, b.x, nloc, nx); b.st[0] = nloc; b.st[1] = nx; }
        const unsigned old = xb_add(&bar[XB_XSUB(b.x)], 1u);
        const unsigned gen = old / nloc;
        if (old + 1u == (gen + 1u) * nloc) {
            __builtin_amdgcn_fence(__ATOMIC_RELEASE, "agent");
            asm volatile("s_waitcnt vmcnt(0)" ::: "memory");
            const unsigned og = xb_add(&bar[XB_TOP], 1u);
            const unsigned tg = og / nx;
            if (og + 1u == (tg + 1u) * nx) xb_add(&bar[XB_TOPGEN], 1u);
            else XB_SPIN(xb_ld(&bar[XB_TOPGEN]) == tg, bar);
            __builtin_amdgcn_fence(__ATOMIC_ACQUIRE, "agent");
            xb_add(&bar[XB_XGEN(b.x)], 1u);
            asm volatile("s_waitcnt vmcnt(0)" ::: "memory");
        } else {
            XB_SPIN(xb_ld(&bar[XB_XGEN(b.x)]) == gen, bar);
            __builtin_amdgcn_fence(__ATOMIC_ACQUIRE, "agent");
            asm volatile("s_waitcnt vmcnt(0)" ::: "memory");
        }
    }
    __syncthreads();
}

struct Args {
    const float *x, *c, *ctx, *cctx, *wmod, *bmod, *normg, *win, *qg, *kg, *convw, *wout, *fg;
    float* out; unsigned char* ws;
    int use_cg, pad;
};

__global__ void __launch_bounds__(NTHREADS, 2) fwd_megakernel(Args a) {
    extern __shared__ __attribute__((aligned(16))) unsigned char lds_raw[];
    cg::grid_group grid = cg::this_grid();
    LAS unsigned char* lds = (LAS unsigned char*)lds_raw;
    const int bid = blockIdx.x, G = gridDim.x;
    const int wave_s = __builtin_amdgcn_readfirstlane(threadIdx.x >> 6);
    const bool leader = (threadIdx.x == 0);
    volatile LAS unsigned* MISC = (volatile LAS unsigned*)(lds + MISC_OFF);
    if (threadIdx.x < 4) MISC[threadIdx.x] = 0u;
    __syncthreads();
    const XcdBarrier xbar = xcd_barrier_post((unsigned*)(a.ws + WS_BAR), MISC, leader);
#define GRID_SEAM() do { if (a.use_cg) grid.sync(); else xcd_barrier(xbar, threadIdx.x == 0); } while (0)
#define PHASE_IDS() const int tid = opaque_tid(wave_s), lane = tid & 63, wave = wave_s; (void)lane; (void)wave
    unsigned char* ws = a.ws;
    float* PART = (float*)(ws + WS_PART); float* GATE = (float*)(ws + WS_GATE); float* SSQ = (float*)(ws + WS_SSQ);
    bf16_t* WIN = (bf16_t*)(ws + WS_WIN); bf16_t* WOUT = (bf16_t*)(ws + WS_WOUT); bf16_t* H = (bf16_t*)(ws + WS_H);
    bf16_t* Qb = (bf16_t*)(ws + WS_Q); bf16_t* KB = (bf16_t*)(ws + WS_K); bf16_t* VB = (bf16_t*)(ws + WS_V);
    bf16_t* GA = (bf16_t*)(ws + WS_GA); bf16_t* Ub = (bf16_t*)(ws + WS_U); bf16_t* Gb = (bf16_t*)(ws + WS_G); bf16_t* MIX = (bf16_t*)(ws + WS_MIX);

    {
        PHASE_IDS();
        p0_adaln(a.c, a.cctx, a.wmod, PART, (LAS float*)lds, tid, wave, lane, bid, G);
        tt_run<0>(a.win, DM, NIN, WIN, NIN / 256, (unsigned*)(ws + WS_BAR) + TT_QUEUE_WORD, 0, 0, lds + 32768, (volatile LAS unsigned*)(lds + XCH_OFF), tid, wave, lane);
    }
    GRID_SEAM();

    {
        PHASE_IDS();
        LAS float* AL0 = (LAS float*)lds; LAS float* SL0 = AL0 + DM; LAS float* AL2 = SL0 + DM; LAS float* SL2 = AL2 + DM;
        for (int idx = bid * NTHREADS + tid; idx < NB * DM; idx += G * NTHREADS) { const int r = idx >> 11, n = (idx & (DM - 1)) + 2 * DM; float s = a.bmod[n];
#pragma unroll
            for (int kc = 0; kc < 8; ++kc) s += PART[((size_t)kc * 3 + r) * 6144 + n];
            GATE[idx] = s; }
        for (int ch = bid; ch < MLAT / 32; ch += G) {
            const int r = ch >> 7;
            __syncthreads();
            { const int n4 = 4 * tid;
                f32x4 sh0 = *(const f32x4*)(a.bmod + n4), sc0 = *(const f32x4*)(a.bmod + DM + n4), sh2 = sh0, sc2 = sc0;
#pragma unroll
                for (int kc = 0; kc < 8; ++kc) { const float* p = PART + (size_t)kc * 3 * 6144;
                    sh0 += *(const f32x4*)(p + r * 6144 + n4); sc0 += *(const f32x4*)(p + r * 6144 + DM + n4); sh2 += *(const f32x4*)(p + 2 * 6144 + n4); sc2 += *(const f32x4*)(p + 2 * 6144 + DM + n4); }
                const f32x4 gn = *(const f32x4*)(a.normg + n4);
                *(LAS f32x4*)(AL0 + n4) = gn * (1.f + sc0); *(LAS f32x4*)(SL0 + n4) = sh0; *(LAS f32x4*)(AL2 + n4) = gn * (1.f + sc2); *(LAS f32x4*)(SL2 + n4) = sh2;
            }
            __syncthreads();
            { const int m = ch * 32 + wave * 4; h_rows<4>(a.x + (size_t)m * DM, H + (size_t)m * DM, AL0, SL0, lane); }
            if (wave < 2) { const int mc = ch * 2 + wave; if (mc < MCTX) h_rows<1>(a.ctx + (size_t)mc * DM, H + (size_t)(MLAT + mc) * DM, AL2, SL2, lane); }
        }
        __syncthreads();
    }
    GRID_SEAM();

    {
        typedef pg8::TileMap<MLAT / 256, NIN / 256, 4, 32, 4, 2> MapIn;
        const int Rfull = MapIn::ntot / G, tail = MapIn::ntot - Rfull * G; const bool split = (2 * tail <= G);
        pg8::Gemm g{H, WIN, MALL, NIN, DM};
        EpiIn E{ws, a.qg, a.kg, a.convw, (LAS float*)(lds + XCH_OFF)};
        const bool has_tail = split && bid < 2 * tail;
        pg8::Unit tu; tu.pm = 0; tu.pn = 0; if (has_tail) MapIn::decode(Rfull * G + (bid >> 1), tu);
        { pg8::StaticOrder<MapIn> S; S.init(G, bid, split ? Rfull * G : MapIn::ntot);
          if (has_tail) pg8::gemm_phase<EpiIn, pg8::StaticOrder<MapIn>, -1, true, false>(lds, g, S, E, wave_s, &tu);
          else          pg8::gemm_phase<EpiIn, pg8::StaticOrder<MapIn>, -1>(lds, g, S, E, wave_s); }
        if (has_tail) { pg8::OneUnit<MapIn> S1{Rfull * G + (bid >> 1)};
            if (bid & 1) pg8::gemm_phase<EpiIn, pg8::OneUnit<MapIn>, 1, false, true>(lds, g, S1, E, wave_s);
            else         pg8::gemm_phase<EpiIn, pg8::OneUnit<MapIn>, 0, false, true>(lds, g, S1, E, wave_s); }
        { PHASE_IDS();
          const int first_idle = (2 * tail <= G) ? 2 * tail : tail, n_idle = first_idle == 0 ? G : G - first_idle, me = first_idle == 0 ? bid : bid - first_idle;
          if (me >= 0) tt_run<1>(a.wout, DM, DM, WOUT, DM / 256, nullptr, me, n_idle, lds + 32768, (volatile LAS unsigned*)(lds + XCH_OFF), tid, wave, lane); }
    }
    GRID_SEAM();

    {
        PHASE_IDS();
        if (bid < 256) {
            const int ui = bid;
            const int xq = ui & 7, idx = (ui >> 3) + 32 * (xq & 1), combo = xq >> 1, b = combo >> 1, kvh = combo & 1, h = kvh * 4 + (idx >> 4), qb = idx & 15;
            const size_t row0 = (size_t)b * SEQ + qb * 256;
            att::attn_dense_body(Qb + row0 * AW + h * HD, KB + (size_t)b * SKV * 256 + kvh * HD, VB + (size_t)b * SKV * 256 + kvh * HD,
                                 GA + row0 * AW + h * HD, MIX + row0 * DM + h * HD, a.qg, a.kg, SKV, (char*)lds_raw, wave_s,
                                 ConvFixHook{Ub, Gb, a.convw, MIX, bid < MLAT / 64 ? bid : -1, tid});
        }
    }
    GRID_SEAM();

    {
        typedef pg8::TileMap<MLAT / 256, DM / 256> MapOut;
        pg8::Gemm g{MIX, WOUT, MLAT, DM, DM}; pg8::OneUnit<MapOut> S{bid < MapOut::ntot ? bid : -1};
        EpiOut E{a.x, a.fg, a.out, ws};
        pg8::gemm_phase<EpiOut, pg8::OneUnit<MapOut>, -1>(lds, g, S, E, wave_s);
    }
}

extern "C" void kernel_launch(void* const* d_in, const int* in_sizes, int n_in, void* d_out, int out_size, void* d_ws, size_t ws_size, hipStream_t stream) {
    static int grid_blocks = 0;
    if (grid_blocks == 0) {
        if (n_in != 13 || in_sizes[0] != MLAT * DM || out_size != MLAT * DM || ws_size < WS_END) { fprintf(stderr, "kernel_launch: shape mismatch (n_in %d in0 %d out %d ws %zu)\n", n_in, n_in > 0 ? in_sizes[0] : -1, out_size, ws_size); grid_blocks = -1; return; }
        int dev = 0, cus = 0, per_cu = 0;
        hipGetDevice(&dev);
        hipDeviceGetAttribute(&cus, hipDeviceAttributeMultiprocessorCount, dev);
        if (hipFuncSetAttribute((const void*)fwd_megakernel, hipFuncAttributeMaxDynamicSharedMemorySize, LDS_BYTES) != hipSuccess) { fprintf(stderr, "kernel_launch: hipFuncSetAttribute failed\n"); grid_blocks = -1; return; }
        if (hipOccupancyMaxActiveBlocksPerMultiprocessor(&per_cu, (const void*)fwd_megakernel, NTHREADS, LDS_BYTES) != hipSuccess || per_cu < 1) { fprintf(stderr, "kernel_launch: occupancy query gave %d\n", per_cu); per_cu = 1; }
        (void)hipGetLastError();
        grid_blocks = cus * per_cu;
        if (grid_blocks > 256) grid_blocks = 256;
    }
    if (grid_blocks < 0) return;
    Args a{};
    a.x = (const float*)d_in[0]; a.c = (const float*)d_in[1]; a.ctx = (const float*)d_in[2]; a.cctx = (const float*)d_in[3];
    a.wmod = (const float*)d_in[4]; a.bmod = (const float*)d_in[5]; a.normg = (const float*)d_in[6]; a.win = (const float*)d_in[7];
    a.qg = (const float*)d_in[8]; a.kg = (const float*)d_in[9]; a.convw = (const float*)d_in[10]; a.wout = (const float*)d_in[11]; a.fg = (const float*)d_in[12];
    a.out = (float*)d_out; a.ws = (unsigned char*)d_ws; a.use_cg = 0; a.pad = 0;
    if (hipMemsetAsync((char*)d_ws + WS_BAR, 0, CTL_BYTES, stream) != hipSuccess) { fprintf(stderr, "kernel_launch: hipMemsetAsync failed\n"); return; }
    void* args[] = {&a};
    hipError_t e = hipLaunchCooperativeKernel((const void*)fwd_megakernel, dim3(grid_blocks), dim3(NTHREADS), args, LDS_BYTES, stream);
    if (e != hipSuccess) fprintf(stderr, "cooperative launch failed: %s (grid %d)\n", hipGetErrorString(e), grid_blocks);
}
```

```cpp
#include <hip/hip_runtime.h>
#include <hip/hip_cooperative_groups.h>
#include <cstdio>
#include <cstdint>
namespace cg = cooperative_groups;

#define LAS __attribute__((address_space(3)))
typedef unsigned short bf16_t;
typedef short bf16x8 __attribute__((ext_vector_type(8)));
typedef short s16x4 __attribute__((ext_vector_type(4)));
typedef float f32x2 __attribute__((ext_vector_type(2)));
typedef float f32x4 __attribute__((ext_vector_type(4)));
typedef float f32x16 __attribute__((ext_vector_type(16)));
typedef unsigned u32x2 __attribute__((ext_vector_type(2)));
typedef unsigned u32x4 __attribute__((ext_vector_type(4)));

constexpr int DM = 2048, NB = 2, SEQ = 4096, CTX = 256, MLAT = NB * SEQ, MCTX = NB * CTX, MALL = MLAT + MCTX;
constexpr int NIN = 6656, HD = 128, NH = 8, NKV = 2, SKV = CTX + SEQ, AW = 1024, CW = 1024;
constexpr float EPS = 1e-6f;
constexpr float QSCALE_F = 0.088388347648318440f * 1.4426950408889634f;
constexpr int NWAVES = 8, NTHREADS = 512;

constexpr size_t MiB = 1u << 20;
constexpr size_t WS_PART = 0;
constexpr size_t WS_BAR  = 768 * 1024;
constexpr int PANEL_CNT_WORD = 4096, TT_QUEUE_WORD = 7168; constexpr size_t CTL_BYTES = 32768;
constexpr size_t WS_GATE = 1 * MiB;
constexpr size_t WS_SSQ  = 2 * MiB;
constexpr size_t WS_WIN  = 4 * MiB;
constexpr size_t WS_WOUT = 30 * MiB;
constexpr size_t WS_H    = 38 * MiB;
constexpr size_t WS_Q    = 72 * MiB;
constexpr size_t WS_K    = 88 * MiB;
constexpr size_t WS_V    = 93 * MiB;
constexpr size_t WS_GA   = 98 * MiB;
constexpr size_t WS_U    = 114 * MiB;
constexpr size_t WS_G    = 130 * MiB;
constexpr size_t WS_MIX  = 146 * MiB;
constexpr size_t WS_END  = 178 * MiB;

constexpr int RING_BYTES = 131072, XCH_OFF = RING_BYTES, MISC_OFF = XCH_OFF + 12288, LDS_BYTES = 147456;

__device__ __forceinline__ unsigned cvt_pk_bf16(float lo, float hi) { unsigned r; asm volatile("v_cvt_pk_bf16_f32 %0, %1, %2" : "=v"(r) : "v"(lo), "v"(hi)); return r; }
__device__ __forceinline__ float bf2f(unsigned short h) { return __builtin_bit_cast(float, (unsigned)h << 16); }
__device__ __forceinline__ float bflo(unsigned w) { return __builtin_bit_cast(float, w << 16); }
__device__ __forceinline__ float bfhi(unsigned w) { return __builtin_bit_cast(float, w & 0xffff0000u); }
__device__ __forceinline__ float silu_f(float x) { return x * __builtin_amdgcn_rcpf(1.f + __builtin_amdgcn_exp2f(-1.4426950408889634f * x)); }
__device__ __forceinline__ float silu_acc(float x) { return x / (1.f + __expf(-x)); }
__device__ __forceinline__ float wave_sum(float v) {
#pragma unroll
    for (int o = 1; o < 64; o <<= 1) v += __shfl_xor(v, o);
    return v;
}
__device__ __forceinline__ int opaque_tid(int wave_s) { int l = __builtin_amdgcn_mbcnt_hi(~0u, __builtin_amdgcn_mbcnt_lo(~0u, 0u)); asm volatile("" : "+v"(l)); return wave_s * 64 + l; }
template <int N> __device__ __forceinline__ float row_ror(float v) { return __builtin_bit_cast(float, __builtin_amdgcn_update_dpp(0, __builtin_bit_cast(int, v), 0x120 + N, 0xf, 0xf, false)); }
#define LDS_WAIT() asm volatile("s_waitcnt lgkmcnt(0)" ::: "memory")

namespace pg8 {
constexpr int BM = 256, BK = 64, HALF = 128, HTB = HALF * BK * 2, STAGE_BYTES = 8 * HTB, NXCD = 8, WGM = 4;
__host__ __device__ __forceinline__ int lds_byte(int r, int c) { const int st = (r >> 4) * 2 + (c >> 5), rr = r & 15, cc = c & 31, ob = rr * 64 + cc * 2; return st * 1024 + (ob ^ (((ob >> 9) & 1) << 5)); }
__host__ __device__ __forceinline__ void stage_rc(int b, int& R, int& C) { const int st = b / 1024, sb = b % 1024, swz = sb ^ (((sb >> 9) & 1) << 5); R = (st >> 1) * 16 + swz / 64; C = (st & 1) * 32 + (swz % 64) / 2; }
__host__ __device__ __forceinline__ int perm32(int rho) { const int n = rho >> 4, i = rho & 15; return 8 * (i >> 2) + 4 * n + (i & 3); }

struct Unit { int pm, pn; };
struct Gemm { const bf16_t* A; const bf16_t* Bt; int M, N, K; };

template <int NM, int NN, int EXTRA = 0, int EPM0 = 0, int EPN0 = 0, int ENN = 1>
struct TileMap {
    static constexpr int nwg = NM * NN, ntot = nwg + EXTRA;
    __device__ static __forceinline__ void decode(int ui, Unit& u) {
        if (EXTRA > 0 && ui >= nwg) { const int j = ui - nwg; u.pm = EPM0 + j / ENN; u.pn = EPN0 + j % ENN; return; }
        int wgid = ui; { constexpr int q = nwg / NXCD, r = nwg % NXCD; const int xcd = wgid % NXCD, off = wgid / NXCD; wgid = (xcd < r ? xcd * (q + 1) : r * (q + 1) + (xcd - r) * q) + off; }
        constexpr int nig = WGM * NN; const int gid = wgid / nig, fm = gid * WGM, gsz = (NM - fm) < WGM ? (NM - fm) : WGM;
        u.pm = fm + ((wgid % nig) % gsz); u.pn = (wgid % nig) / gsz;
    }
};
template <class Map> struct StaticOrder {
    int G, c, limit;
    __device__ __forceinline__ void init(int G_, int c_, int limit_) { G = G_; c = c_; limit = limit_; }
    __device__ __forceinline__ bool next(int i, Unit& u) const { const int L = i * G + c; if (L >= limit) return false; Map::decode(L, u); return true; }
};
template <class Map> struct OneUnit {
    int ui;
    __device__ __forceinline__ bool next(int i, Unit& u) const { if (i != 0 || ui < 0) return false; Map::decode(ui, u); return true; }
};

template <class Epi, class Sched, int RH = -1, bool PROLOGUE = true, bool DRAIN = true>
__device__ __forceinline__ void gemm_phase(LAS unsigned char* lds, const Gemm g, const Sched& S, const Epi& E, int wave_s, const Unit* handoff = nullptr) {
    const int tid = opaque_tid(wave_s), wid = wave_s, lane = tid & 63, wr = wid >> 2, wc = wid & 3, fr = lane & 15, fq = lane >> 4;
    const int K = g.K, nt = K / BK;
    unsigned voffA[2], voffB[2];
#pragma unroll
    for (int i = 0; i < 2; ++i) { int R, C; stage_rc(tid * 16 + i * 8192, R, C); const int Rb = (R & ~31) + perm32(R & 31);
        voffA[i] = (unsigned)(R * K + C) * 2u; voffB[i] = (unsigned)(Rb * K + C) * 2u; }
    const size_t kstep = (size_t)(BK * 2);
    const size_t hstep = (size_t)HALF * K * 2;
    const size_t tstep = 2 * hstep;
    const unsigned ldsw = (unsigned)wid * 1024u;
    const int aoff = lds_byte(wr * 64 + fr, fq * 8), boff = lds_byte(wc * 32 + fr, fq * 8);
#define PG8_SA(b, h) (((b) * 2 + (h)) * HTB)
#define PG8_SB(b, h) ((4 + (b) * 2 + (h)) * HTB)
#define PG8_STAGE(bufoff, gbase, voff) do { _Pragma("unroll") for (int _i = 0; _i < 2; ++_i) \
        __builtin_amdgcn_global_load_lds((const unsigned*)((const char*)(gbase) + (voff)[_i]), (LAS unsigned*)(lds + (bufoff) + ldsw + _i * 8192), 16, 0, 0); } while (0)
#define PG8_LDA(dst, b, h) do { _Pragma("unroll") for (int m = 0; m < 4; ++m) _Pragma("unroll") for (int k = 0; k < 2; ++k) dst[m][k] = *(const LAS bf16x8*)(lds + PG8_SA(b, h) + aoff + m * 2048 + k * 1024); } while (0)
#define PG8_LDB(dst, b, h) do { _Pragma("unroll") for (int n = 0; n < 2; ++n) _Pragma("unroll") for (int k = 0; k < 2; ++k) dst[n][k] = *(const LAS bf16x8*)(lds + PG8_SB(b, h) + boff + n * 2048 + k * 1024); } while (0)
#define PG8_MMA(ai, bj, At, Bt) do { __builtin_amdgcn_s_setprio(1); _Pragma("unroll") for (int m = 0; m < 4; ++m) _Pragma("unroll") for (int n = 0; n < 2; ++n) _Pragma("unroll") for (int k = 0; k < 2; ++k) \
        acc[ai][bj][m][n] = __builtin_amdgcn_mfma_f32_16x16x32_bf16(Bt[n][k], At[m][k], acc[ai][bj][m][n], 0, 0, 0); __builtin_amdgcn_s_setprio(0); } while (0)
#define PG8_WAIT_V(n) asm volatile("s_waitcnt vmcnt(" #n ")" ::: "memory")
#define PG8_WAIT_L(n) asm volatile("s_waitcnt lgkmcnt(" #n ")" ::: "memory")
#define PG8_BAR __builtin_amdgcn_s_barrier()
#define PG8_SCHED __builtin_amdgcn_sched_barrier(0)
    Unit cur, nxt; int ui = 0;
    if (!S.next(0, cur)) return;
    f32x4 acc[2][2][4][2];
#pragma unroll
    for (int a = 0; a < 2; ++a)
#pragma unroll
        for (int b = 0; b < 2; ++b)
#pragma unroll
            for (int m = 0; m < 4; ++m)
#pragma unroll
                for (int n = 0; n < 2; ++n) acc[a][b][m][n] = (f32x4){0.f, 0.f, 0.f, 0.f};
    bf16x8 At[4][2], B0[2][2], B1[2][2];
    const char* cA = (const char*)g.A + (size_t)cur.pm * tstep; const char* cB = (const char*)g.Bt + (size_t)cur.pn * tstep;
    if constexpr (PROLOGUE) {
    PG8_STAGE(PG8_SB(0, 0), cB, voffB); PG8_STAGE(PG8_SB(0, 1), cB + hstep, voffB); PG8_STAGE(PG8_SA(0, 0), cA, voffA); PG8_STAGE(PG8_SA(0, 1), cA + hstep, voffA);
    if (wr == 1) PG8_BAR;
    PG8_WAIT_V(2); PG8_BAR;
    PG8_STAGE(PG8_SB(1, 0), cB + kstep, voffB); PG8_STAGE(PG8_SA(1, 0), cA + kstep, voffA); PG8_STAGE(PG8_SB(1, 1), cB + hstep + kstep, voffB);
    PG8_WAIT_V(6); PG8_BAR;
    }
    for (;;) {
        const bool has_next = S.next(ui + 1, nxt);
        constexpr bool do0 = RH != 1, do1 = RH != 0;
        const bool chain = !has_next && !DRAIN && handoff != nullptr;
        const Unit pre = chain ? *handoff : nxt; const bool has_pref = has_next || chain;
        const char* nA = has_pref ? (const char*)g.A + (size_t)pre.pm * tstep : cA; const char* nB = has_pref ? (const char*)g.Bt + (size_t)pre.pn * tstep : cB;
        for (int t = 0; t < nt; t += 2) {
            const bool last = (t == nt - 2);
            const char* a1 = cA + (size_t)(t + 1) * kstep;
            const char* a2 = last ? nA : cA + (size_t)(t + 2) * kstep; const char* b2 = last ? nB : cB + (size_t)(t + 2) * kstep;
            const char* a3 = a2 + kstep; const char* b3 = b2 + kstep;
            PG8_LDB(B0, 0, 0); PG8_LDB(B1, 0, 1); PG8_SCHED; if (do0) PG8_LDA(At, 0, 0); PG8_STAGE(PG8_SA(1, 1), a1 + hstep, voffA);
            PG8_WAIT_V(8); PG8_WAIT_L(0); PG8_BAR; if (do0) { PG8_MMA(0, 0, At, B0); PG8_MMA(0, 1, At, B1); } PG8_BAR; PG8_SCHED;
            if (do1) PG8_LDA(At, 0, 1); PG8_STAGE(PG8_SB(0, 0), b2, voffB); PG8_STAGE(PG8_SB(0, 1), b2 + hstep, voffB); PG8_STAGE(PG8_SA(0, 0), a2, voffA);
            PG8_WAIT_V(8); PG8_WAIT_L(0); PG8_BAR; if (do1) { PG8_MMA(1, 0, At, B0); PG8_MMA(1, 1, At, B1); } PG8_BAR; PG8_SCHED;
            PG8_LDB(B0, 1, 0); PG8_LDB(B1, 1, 1); PG8_SCHED; if (do0) PG8_LDA(At, 1, 0); PG8_STAGE(PG8_SA(0, 1), a2 + hstep, voffA);
            PG8_WAIT_V(8); PG8_WAIT_L(0); PG8_BAR; if (do0) { PG8_MMA(0, 0, At, B0); PG8_MMA(0, 1, At, B1); } PG8_BAR; PG8_SCHED;
            if (do1) PG8_LDA(At, 1, 1); PG8_STAGE(PG8_SB(1, 0), b3, voffB); PG8_STAGE(PG8_SB(1, 1), b3 + hstep, voffB); PG8_STAGE(PG8_SA(1, 0), a3, voffA);
            PG8_WAIT_V(8); PG8_WAIT_L(0); PG8_BAR; if (do1) { PG8_MMA(1, 0, At, B0); PG8_MMA(1, 1, At, B1); } PG8_BAR; PG8_SCHED;
        }
        if (wr == 0) PG8_BAR;
        E.template run<RH>(acc, cur, wr, wc, fr, fq);
        if (!has_next) break;
#pragma unroll
        for (int a = 0; a < 2; ++a)
#pragma unroll
            for (int b = 0; b < 2; ++b)
#pragma unroll
                for (int m = 0; m < 4; ++m)
#pragma unroll
                    for (int n = 0; n < 2; ++n) acc[a][b][m][n] = (f32x4){0.f, 0.f, 0.f, 0.f};
        cur = nxt; cA = nA; cB = nB; ++ui;
        if (wr == 1) PG8_BAR;
    }
    if constexpr (DRAIN) { PG8_WAIT_V(0); PG8_BAR; }
    else { if (handoff != nullptr) { if (wr == 1) PG8_BAR; } else { PG8_WAIT_V(0); PG8_BAR; } }
#undef PG8_SA
#undef PG8_SB
#undef PG8_STAGE
#undef PG8_LDA
#undef PG8_LDB
#undef PG8_MMA
#undef PG8_WAIT_V
#undef PG8_WAIT_L
#undef PG8_BAR
#undef PG8_SCHED
}
}

__host__ __device__ __forceinline__ int win_src_col(int n) {
    if (n < 1280) { const int hb = n & ~127, s = n & 127, p = s >> 1, e = s & 1; return hb + (p < 32 ? p : p + 32) + 32 * e; }
    if (n < 2560) return n;
    const int t = n - 2560, ct = t >> 8, w = t & 255, half = w >> 7, s = w & 127, ch = ct * 64 + (s >> 1), e = s & 1;
    const int sec = half == 0 ? (e == 0 ? 3584 : 4608) : (e == 0 ? 2560 : 5632);
    return sec + ch;
}
struct EpiIn {
    unsigned char* ws; const float *qg, *kg, *convw; LAS float* P;
    template <int RH> __device__ __forceinline__ void run(f32x4 (&acc)[2][2][4][2], const pg8::Unit& u, int wr, int wc, int fr, int fq) const {
        asm volatile("" : "+v"(fr), "+v"(fq));
        const int pn = u.pn, pm = u.pm;
        bf16_t* const Q = (bf16_t*)(ws + WS_Q); bf16_t* const KB = (bf16_t*)(ws + WS_K); bf16_t* const VB = (bf16_t*)(ws + WS_V);
        bf16_t* const GA = (bf16_t*)(ws + WS_GA); bf16_t* const U = (bf16_t*)(ws + WS_U); bf16_t* const G = (bf16_t*)(ws + WS_G);
        const int rl0 = wr * 64 + fr;
        const bool isctx = pm >= 32;
        const int kvrow0 = isctx ? (pm - 32) * SKV : (pm >> 4) * SKV + CTX + (pm & 15) * 256;
        if (pn <= 4) {
            const bool isk = (pn == 4);
            const float* gw = isk ? kg : qg;
            float g1[2][2], g2[2][2], invf[2][2];
#pragma unroll
            for (int n = 0; n < 2; ++n)
#pragma unroll
                for (int jj = 0; jj < 2; ++jj) { const int p = 16 * wc + 4 * fq + 2 * n + jj, d1 = p < 32 ? p : p + 32;
                    g1[n][jj] = gw[d1]; g2[n][jj] = gw[d1 + 32]; invf[n][jj] = exp2f(-(float)(p & 31) * 0.41524101186092029f) * 0.15915494309189535f; }
#pragma unroll
            for (int ai = 0; ai < 2; ++ai) if (RH < 0 || ai == RH)
#pragma unroll
                for (int m = 0; m < 4; ++m)
#pragma unroll
                    for (int bj = 0; bj < 2; ++bj) { const f32x4 a = acc[ai][bj][m][0], b = acc[ai][bj][m][1];
                        float s = (a[0] * a[0] + a[1] * a[1]) + (a[2] * a[2] + a[3] * a[3]) + (b[0] * b[0] + b[1] * b[1]) + (b[2] * b[2] + b[3] * b[3]);
                        s += __shfl_xor(s, 16); s += __shfl_xor(s, 32);
                        if (fq == 0) P[((ai * 128 + rl0 + 16 * m) * 2 + bj) * 4 + wc] = s; }
            LDS_WAIT(); __builtin_amdgcn_s_barrier();
            bf16_t* obase; int ld;
            if (isk) { obase = KB + (size_t)kvrow0 * 256; ld = 256; } else { obase = Q + (size_t)pm * 256 * 1024 + pn * 256; ld = 1024; }
#pragma unroll
            for (int ai = 0; ai < 2; ++ai) if (RH < 0 || ai == RH)
#pragma unroll
                for (int m = 0; m < 4; ++m) { const int rl = ai * 128 + rl0 + 16 * m; const int t = (pm & 15) * 256 + rl;
                    const float pos = (float)(wc < 2 ? (t >> 6) : (t & 63));
                    float cs[2][2], sn[2][2];
#pragma unroll
                    for (int n = 0; n < 2; ++n)
#pragma unroll
                        for (int jj = 0; jj < 2; ++jj) { float rev = pos * invf[n][jj]; rev -= floorf(rev);
                            cs[n][jj] = isctx ? 1.f : __builtin_amdgcn_cosf(rev); sn[n][jj] = isctx ? 0.f : __builtin_amdgcn_sinf(rev); }
#pragma unroll
                    for (int bj = 0; bj < 2; ++bj) { const f32x4 pp = *(const LAS f32x4*)(P + (rl * 2 + bj) * 4);
                        const float rstd = rsqrtf(((pp[0] + pp[1]) + (pp[2] + pp[3])) * (1.f / 128.f) + EPS) * (isk ? 1.f : QSCALE_F);
                        unsigned w[4];
#pragma unroll
                        for (int n = 0; n < 2; ++n)
#pragma unroll
                            for (int jj = 0; jj < 2; ++jj) { const float x1 = acc[ai][bj][m][n][2 * jj] * rstd * g1[n][jj], x2 = acc[ai][bj][m][n][2 * jj + 1] * rstd * g2[n][jj];
                                w[2 * n + jj] = cvt_pk_bf16(x1 * cs[n][jj] - x2 * sn[n][jj], x2 * cs[n][jj] + x1 * sn[n][jj]); }
                        *(u32x4*)(obase + (size_t)rl * ld + bj * 128 + 32 * wc + 8 * fq) = (u32x4){w[0], w[1], w[2], w[3]}; } }
        } else if (pn == 5) {
#pragma unroll
            for (int ai = 0; ai < 2; ++ai) if (RH < 0 || ai == RH)
#pragma unroll
                for (int m = 0; m < 4; ++m) { const int rl = ai * 128 + rl0 + 16 * m;
#pragma unroll
                    for (int bj = 0; bj < 2; ++bj) { const f32x4 a = acc[ai][bj][m][0], b = acc[ai][bj][m][1];
                        *(u32x4*)(VB + (size_t)(kvrow0 + rl) * 256 + bj * 128 + 32 * wc + 8 * fq) = (u32x4){cvt_pk_bf16(a[0], a[1]), cvt_pk_bf16(a[2], a[3]), cvt_pk_bf16(b[0], b[1]), cvt_pk_bf16(b[2], b[3])}; } }
        } else if (pn < 10) {
#pragma unroll
            for (int ai = 0; ai < 2; ++ai) if (RH < 0 || ai == RH)
#pragma unroll
                for (int m = 0; m < 4; ++m) { const int rl = ai * 128 + rl0 + 16 * m;
#pragma unroll
                    for (int bj = 0; bj < 2; ++bj) { const f32x4 a = acc[ai][bj][m][0], b = acc[ai][bj][m][1];
                        *(u32x4*)(GA + (size_t)(pm * 256 + rl) * 1024 + (pn - 6) * 256 + bj * 128 + 32 * wc + 8 * fq) =
                            (u32x4){cvt_pk_bf16(silu_f(a[0]), silu_f(a[1])), cvt_pk_bf16(silu_f(a[2]), silu_f(a[3])), cvt_pk_bf16(silu_f(b[0]), silu_f(b[1])), cvt_pk_bf16(silu_f(b[2]), silu_f(b[3]))}; } }
        } else {
            const int cl = 16 * wc + 4 * fq, ch0 = (pn - 10) * 64 + cl;
            bf16_t* const MIXp = (bf16_t*)(ws + WS_MIX);
            float cw0[4], cw1[4], cw2[4];
#pragma unroll
            for (int q = 0; q < 4; ++q) { cw0[q] = convw[ch0 + q]; cw1[q] = convw[CW + ch0 + q]; cw2[q] = convw[2 * CW + ch0 + q]; }
            LAS float* E = P + 2048;
#pragma unroll
            for (int ai = 0; ai < 2; ++ai) if (RH < 0 || ai == RH) {
#pragma unroll
                for (int q = 0; q < 4; ++q) { const f32x4 cf = acc[ai][0][0][q >> 1], cl4 = acc[ai][0][3][q >> 1];
                    if (fr == 0)  E[((ai * 2 + wr) * 2 + 0) * 64 + cl + q] = cf[2 * (q & 1)] * cf[2 * (q & 1) + 1];
                    if (fr == 15) E[((ai * 2 + wr) * 2 + 1) * 64 + cl + q] = cl4[2 * (q & 1)] * cl4[2 * (q & 1) + 1]; } }
            LDS_WAIT(); __builtin_amdgcn_s_barrier(); asm volatile("" ::: "memory");
#pragma unroll
            for (int ai = 0; ai < 2; ++ai) if (RH < 0 || ai == RH) {
                float u[4][4], g[4][4];
#pragma unroll
                for (int m = 0; m < 4; ++m)
#pragma unroll
                    for (int q = 0; q < 4; ++q) { const f32x4 c = acc[ai][0][m][q >> 1], d = acc[ai][1][m][q >> 1];
                        u[m][q] = c[2 * (q & 1)] * c[2 * (q & 1) + 1]; g[m][q] = d[2 * (q & 1)] * silu_f(d[2 * (q & 1) + 1]); }
                float eprev[4], enext[4];
#pragma unroll
                for (int q = 0; q < 4; ++q) { eprev[q] = E[((ai * 2 + 0) * 2 + 1) * 64 + cl + q]; enext[q] = E[((ai * 2 + 1) * 2 + 0) * 64 + cl + q]; }
#pragma unroll
                for (int m = 0; m < 4; ++m) { const int rl = 64 * wr + 16 * m + fr;
                    const size_t row = (size_t)pm * 256 + ai * 128 + rl;
                    float o[4];
#pragma unroll
                    for (int q = 0; q < 4; ++q) {
                        const float sp = row_ror<1>(u[m][q]), spb = (m > 0) ? row_ror<1>(u[m > 0 ? m - 1 : 0][q]) : eprev[q];
                        const float sn = row_ror<15>(u[m][q]), snb = (m < 3) ? row_ror<15>(u[m < 3 ? m + 1 : 3][q]) : enext[q];
                        const float pv = (fr == 0) ? spb : sp, nx = (fr == 15) ? snb : sn;
                        o[q] = g[m][q] * (cw0[q] * pv + cw1[q] * u[m][q] + cw2[q] * nx); }
                    if (rl != 0 && rl != 127) *(u32x2*)(MIXp + row * DM + AW + ch0) = (u32x2){cvt_pk_bf16(o[0], o[1]), cvt_pk_bf16(o[2], o[3])};
                    if (rl <= 1 || rl >= 126) *(u32x2*)(U + row * CW + ch0) = (u32x2){cvt_pk_bf16(u[m][0], u[m][1]), cvt_pk_bf16(u[m][2], u[m][3])};
                    if (rl == 0 || rl == 127) *(u32x2*)(G + row * CW + ch0) = (u32x2){cvt_pk_bf16(g[m][0], g[m][1]), cvt_pk_bf16(g[m][2], g[m][3])}; }
            }
        }
    }
};

__device__ __forceinline__ unsigned xch_ld(unsigned* p)              { return __hip_atomic_load(p, __ATOMIC_RELAXED, __HIP_MEMORY_SCOPE_AGENT); }
__device__ __forceinline__ unsigned xch_add(unsigned* p, unsigned v) { return __hip_atomic_fetch_add(p, v, __ATOMIC_RELAXED, __HIP_MEMORY_SCOPE_AGENT); }
struct EpiOut {
    const float* x; const float* fg; float* out; unsigned char* ws;
    template <int RH> __device__ __forceinline__ void run(f32x4 (&acc)[2][2][4][2], const pg8::Unit& u, int wr, int wc, int fr, int fq) const {
        static_assert(RH < 0, "whole tiles only");
        const int pm = u.pm, pn = u.pn, b = pm >> 4;
        const float* const gate = (const float*)(ws + WS_GATE); float* const ssq = (float*)(ws + WS_SSQ); unsigned* const cnt = (unsigned*)(ws + WS_BAR) + PANEL_CNT_WORD;
        const int col0 = pn * 256 + 32 * wc + 8 * fq;
        {
            f32x4 gt[2][2];
#pragma unroll
            for (int bj = 0; bj < 2; ++bj)
#pragma unroll
                for (int n = 0; n < 2; ++n) gt[bj][n] = *(const f32x4*)(gate + b * DM + col0 + bj * 128 + 4 * n);
#pragma unroll
            for (int ai = 0; ai < 2; ++ai)
#pragma unroll
                for (int m = 0; m < 4; ++m) { const int row = pm * 256 + ai * 128 + wr * 64 + 16 * m + fr; float ss = 0.f;
#pragma unroll
                    for (int bj = 0; bj < 2; ++bj)
#pragma unroll
                        for (int n = 0; n < 2; ++n) { const f32x4 xv = *(const f32x4*)(x + (size_t)row * DM + col0 + bj * 128 + 4 * n); const f32x4 y = xv + gt[bj][n] * acc[ai][bj][m][n];
                            acc[ai][bj][m][n] = y; ss += (y[0] * y[0] + y[1] * y[1]) + (y[2] * y[2] + y[3] * y[3]); }
                    ss += __shfl_xor(ss, 16); ss += __shfl_xor(ss, 32);
                    if (fq == 0) __hip_atomic_store((unsigned*)ssq + (size_t)row * 32 + pn * 4 + wc, __float_as_uint(ss), __ATOMIC_RELAXED, __HIP_MEMORY_SCOPE_AGENT); }
        }
        asm volatile("s_waitcnt vmcnt(0)" ::: "memory");
        __syncthreads();
        if (wr == 0 && wc == 0 && fr == 0 && fq == 0) {
            unsigned* c = cnt + 64 * pm;
            (void)xch_add(c, 1u);
            unsigned sp = 0u; while (xch_ld(c) < 8u) { __builtin_amdgcn_s_sleep(1); if (++sp > (1u << 20)) break; }
        }
        __syncthreads();
        f32x4 fgv[2][2];
#pragma unroll
        for (int bj = 0; bj < 2; ++bj)
#pragma unroll
            for (int n = 0; n < 2; ++n) fgv[bj][n] = *(const f32x4*)(fg + col0 + bj * 128 + 4 * n);
#pragma unroll
        for (int ai = 0; ai < 2; ++ai)
#pragma unroll
            for (int m = 0; m < 4; ++m) { const int row = pm * 256 + ai * 128 + wr * 64 + 16 * m + fr;
                const unsigned long long* p = (const unsigned long long*)(ssq + (size_t)row * 32 + 8 * fq);
                const unsigned long long q0 = __hip_atomic_load(p, __ATOMIC_RELAXED, __HIP_MEMORY_SCOPE_AGENT), q1 = __hip_atomic_load(p + 1, __ATOMIC_RELAXED, __HIP_MEMORY_SCOPE_AGENT),
                                         q2 = __hip_atomic_load(p + 2, __ATOMIC_RELAXED, __HIP_MEMORY_SCOPE_AGENT), q3 = __hip_atomic_load(p + 3, __ATOMIC_RELAXED, __HIP_MEMORY_SCOPE_AGENT);
#define LOF(q) __uint_as_float((unsigned)(q))
#define HIF(q) __uint_as_float((unsigned)((q) >> 32))
                float s = ((LOF(q0) + HIF(q0)) + (LOF(q1) + HIF(q1))) + ((LOF(q2) + HIF(q2)) + (LOF(q3) + HIF(q3)));
#undef LOF
#undef HIF
                s += __shfl_xor(s, 16); s += __shfl_xor(s, 32);
                const float rstd = rsqrtf(s * (1.f / DM) + EPS);
#pragma unroll
                for (int bj = 0; bj < 2; ++bj)
#pragma unroll
                    for (int n = 0; n < 2; ++n) __builtin_nontemporal_store(acc[ai][bj][m][n] * rstd * fgv[bj][n], (f32x4*)(out + (size_t)row * DM + col0 + bj * 128 + 4 * n)); }
    }
};

struct ConvFixHook {
    const bf16_t* Ub; const bf16_t* Gb; const float* convw; bf16_t* MIX; int e, tid;
    __device__ __forceinline__ void operator()() const {
        if (e >= 0 && tid < 128) { const int ch0 = tid * 8, m = (e >> 1) * 128 + ((e & 1) ? 127 : 0);
            const u32x4 z = {0u, 0u, 0u, 0u};
            const u32x4 up = ((m & (SEQ - 1)) == 0) ? z : *(const u32x4*)(Ub + (size_t)(m - 1) * CW + ch0);
            const u32x4 uc = *(const u32x4*)(Ub + (size_t)m * CW + ch0);
            const u32x4 un = ((m & (SEQ - 1)) == SEQ - 1) ? z : *(const u32x4*)(Ub + (size_t)(m + 1) * CW + ch0);
            const u32x4 gg = *(const u32x4*)(Gb + (size_t)m * CW + ch0);
            unsigned o[4];
#pragma unroll
            for (int q = 0; q < 4; ++q) {
                const float w0l = convw[ch0 + 2 * q], w0h = convw[ch0 + 2 * q + 1], w1l = convw[CW + ch0 + 2 * q], w1h = convw[CW + ch0 + 2 * q + 1], w2l = convw[2 * CW + ch0 + 2 * q], w2h = convw[2 * CW + ch0 + 2 * q + 1];
                const float lo = bflo(gg[q]) * (w0l * bflo(up[q]) + w1l * bflo(uc[q]) + w2l * bflo(un[q]));
                const float hi = bfhi(gg[q]) * (w0h * bfhi(up[q]) + w1h * bfhi(uc[q]) + w2h * bfhi(un[q]));
                o[q] = cvt_pk_bf16(lo, hi); }
            *(u32x4*)(MIX + (size_t)m * DM + AW + ch0) = (u32x4){o[0], o[1], o[2], o[3]}; }
    }
};

namespace att {
constexpr int D = 128, QBLK = 32, KVBLK = 64;
constexpr float SCALE = 0.088388347648318440f, QSCALE = SCALE * 1.4426950408889634f;
constexpr int LDQ = 1024, LDK = 256;
constexpr int NBUF = 3;
constexpr size_t SHM_V = KVBLK * D * 2, SHM_K = KVBLK * D * 2, SHM_ATTN = NBUF * (SHM_V + SHM_K) + NWAVES * 64 * 4;
constexpr int OST_PITCH = 272, OST_WAVE = 32 * OST_PITCH;
constexpr size_t WS_OFF = NBUF * (SHM_V + SHM_K);
static_assert(WS_OFF >= 8 * (size_t)OST_WAVE, "O staging below the l words");
#define KSWZ(row, colB) ((row) * 256 + ((colB) ^ (((row) & 7) << 4)))
#define SBAR() __builtin_amdgcn_sched_barrier(0)
__device__ __forceinline__ int crow(int r, int hi) { return (r & 3) + 8 * (r >> 2) + 4 * hi; }
__device__ __forceinline__ void expHalf(f32x16& p) {
#pragma unroll
  for (int r = 0; r < 16; ++r) p[r] = __builtin_amdgcn_exp2f(p[r]);
}
__device__ __forceinline__ void finishSM(f32x16& p0, f32x16& p1, float& l_reg, bf16x8& pa0, bf16x8& pa1, bf16x8& pa2, bf16x8& pa3) {
  expHalf(p1);
  float ps = 0;
#pragma unroll
  for (int r = 0; r < 16; ++r) ps += p0[r];
#pragma unroll
  for (int r = 0; r < 16; ++r) ps += p1[r];
  { auto rr = __builtin_amdgcn_permlane32_swap(__float_as_uint(ps), __float_as_uint(ps), false, false);
    ps = __uint_as_float(rr[0]) + __uint_as_float(rr[1]); }
  l_reg += ps;
#define PK4(P, BASE, OUT) do { unsigned a0 = cvt_pk_bf16(P[BASE + 0], P[BASE + 1]), a1 = cvt_pk_bf16(P[BASE + 2], P[BASE + 3]);   \
    unsigned b0 = cvt_pk_bf16(P[BASE + 4], P[BASE + 5]), b1 = cvt_pk_bf16(P[BASE + 6], P[BASE + 7]);                              \
    auto r0 = __builtin_amdgcn_permlane32_swap(a0, b0, false, false); auto r1 = __builtin_amdgcn_permlane32_swap(a1, b1, false, false); \
    u32x4 w = {r0[0], r1[0], r0[1], r1[1]}; OUT = *reinterpret_cast<bf16x8*>(&w); } while (0)
  PK4(p0, 0, pa0); PK4(p0, 8, pa1); PK4(p1, 0, pa2); PK4(p1, 8, pa3);
#undef PK4
}
__device__ __forceinline__ void qkt(f32x16& p0, f32x16& p1, const char* Ks, const bf16x8* qr, int r32, int hi, float init) {
#pragma unroll
  for (int r = 0; r < 16; ++r) { p0[r] = init; p1[r] = init; }
#define KLD(d0, half) (*reinterpret_cast<const bf16x8*>(Ks + KSWZ((half) * 32 + r32, ((d0) * 16 + hi * 8) * 2)))
  bf16x8 a0 = KLD(0, 0), a1 = KLD(0, 1);
  __builtin_amdgcn_s_setprio(1);
#pragma unroll
  for (int d0 = 0; d0 < 8; ++d0) {
    bf16x8 n0 = a0, n1 = a1;
    if (d0 < 7) { n0 = KLD(d0 + 1, 0); n1 = KLD(d0 + 1, 1); }
    p0 = __builtin_amdgcn_mfma_f32_32x32x16_bf16(a0, qr[d0], p0, 0, 0, 0);
    p1 = __builtin_amdgcn_mfma_f32_32x32x16_bf16(a1, qr[d0], p1, 0, 0, 0);
    a0 = n0; a1 = n1; }
  __builtin_amdgcn_s_setprio(0);
#undef KLD
}
__device__ __forceinline__ int v_st(int k, int c) { const int kk = (k & ~0xC) | ((k & 4) << 1) | ((k & 8) >> 1); return ((kk >> 3) * 4 + (c >> 5)) * 512 + ((kk & 7) * 32 + (c & 31)) * 2; }
__device__ __forceinline__ int v_rd_base(int lane) { return ((lane & 3) << 3) | (((lane >> 2) & 3) << 6) | (((lane >> 4) & 1) << 5) | (((lane >> 5) & 1) << 8); }
constexpr int v_rd_off(int d0, int ks, int half) { return d0 * 512 + ks * 4096 + half * 2048; }
template <int OFF> __device__ __forceinline__ s16x4 tr_read(int vb) {
  s16x4 r; asm volatile("ds_read_b64_tr_b16 %0, %1 offset:%2" : "=&v"(r) : "v"(vb), "i"(OFF) : "memory"); return r;
}
struct VFrag { s16x4 l0, h0, l1, h1, l2, h2, l3, h3; };
template <int D0> __device__ __forceinline__ void pv_rd(VFrag& f, int vb) {
  f.l0 = tr_read<v_rd_off(D0, 0, 0)>(vb); f.h0 = tr_read<v_rd_off(D0, 0, 1)>(vb); f.l1 = tr_read<v_rd_off(D0, 1, 0)>(vb); f.h1 = tr_read<v_rd_off(D0, 1, 1)>(vb);
  f.l2 = tr_read<v_rd_off(D0, 2, 0)>(vb); f.h2 = tr_read<v_rd_off(D0, 2, 1)>(vb); f.l3 = tr_read<v_rd_off(D0, 3, 0)>(vb); f.h3 = tr_read<v_rd_off(D0, 3, 1)>(vb);
}
__device__ __forceinline__ void pv_mm(f32x16& od, const VFrag& f, bf16x8 pa0, bf16x8 pa1, bf16x8 pa2, bf16x8 pa3) {
#define PK(L, H) (bf16x8){L[0], L[1], L[2], L[3], H[0], H[1], H[2], H[3]}
  __builtin_amdgcn_s_setprio(1);
  od = __builtin_amdgcn_mfma_f32_32x32x16_bf16(pa0, PK(f.l0, f.h0), od, 0, 0, 0);
  od = __builtin_amdgcn_mfma_f32_32x32x16_bf16(pa1, PK(f.l1, f.h1), od, 0, 0, 0);
  od = __builtin_amdgcn_mfma_f32_32x32x16_bf16(pa2, PK(f.l2, f.h2), od, 0, 0, 0);
  od = __builtin_amdgcn_mfma_f32_32x32x16_bf16(pa3, PK(f.l3, f.h3), od, 0, 0, 0);
  __builtin_amdgcn_s_setprio(0);
#undef PK
}
__device__ __forceinline__ void pv_d0(f32x16* o, int vb, bf16x8 pa0, bf16x8 pa1, bf16x8 pa2, bf16x8 pa3) {
  VFrag fa, fb;
  pv_rd<0>(fa, vb); pv_rd<1>(fb, vb);
  asm volatile("s_waitcnt lgkmcnt(8)" ::: "memory"); SBAR(); pv_mm(o[0], fa, pa0, pa1, pa2, pa3); SBAR();
  pv_rd<2>(fa, vb);
  asm volatile("s_waitcnt lgkmcnt(8)" ::: "memory"); SBAR(); pv_mm(o[1], fb, pa0, pa1, pa2, pa3); SBAR();
  pv_rd<3>(fb, vb);
  asm volatile("s_waitcnt lgkmcnt(8)" ::: "memory"); SBAR(); pv_mm(o[2], fa, pa0, pa1, pa2, pa3); SBAR();
  asm volatile("s_waitcnt lgkmcnt(0)" ::: "memory"); SBAR(); pv_mm(o[3], fb, pa0, pa1, pa2, pa3);
}
template <class Hook>
__device__ __forceinline__ void attn_dense_body(const bf16_t* __restrict__ Qb, const bf16_t* __restrict__ Kh, const bf16_t* __restrict__ Vh,
                                                const bf16_t* __restrict__ GAb, bf16_t* __restrict__ MIXb, const float* __restrict__ qg, const float* __restrict__ kg, int seq, char* lds, int wave_s, const Hook& hook) {
  const int tid = opaque_tid(wave_s), wid = wave_s, lane = tid & 63, r32 = lane & 31, hi = lane >> 5;
  char* V_lds = lds; char* K_lds = lds + NBUF * SHM_V;
#define TO_LAS(p) ((LAS unsigned char*)(unsigned)(uintptr_t)(p))
  float* ws = (float*)(lds + WS_OFF) + wid * 64; float* li_l = ws;
  float l_reg = 0; f32x16 o[4] = {}; bf16x8 qr[8];
  float init;
  { float gq = fmaxf(fabsf(qg[lane]), fabsf(qg[lane + 64])), gk = fmaxf(fabsf(kg[lane]), fabsf(kg[lane + 64]));
#pragma unroll
    for (int ofs = 1; ofs < 64; ofs <<= 1) { gq = fmaxf(gq, __shfl_xor(gq, ofs)); gk = fmaxf(gk, __shfl_xor(gk, ofs)); }
    init = -(QSCALE * 128.f * 1.02f) * gq * gk; }
  const bf16_t* Qw = Qb + (long)(wid * QBLK + r32) * LDQ + hi * 8;
#pragma unroll
  for (int d0 = 0; d0 < 8; ++d0) qr[d0] = *reinterpret_cast<const bf16x8*>(Qw + d0 * 16);
  const int vb0 = (int)(uintptr_t)V_lds + v_rd_base(lane);
  int koff[2], voff[2];
#pragma unroll
  for (int i = 0; i < 2; ++i) { const int p = (i * 8 + wid) * 64 + lane;
    { const int row = p >> 4, c = (p & 15) ^ (row & 7); koff[i] = row * LDK + c * 8; }
    { const int S = p >> 5, within = p & 31, kk = (S >> 2) * 8 + (within >> 2), k = (kk & ~0xC) | ((kk & 4) << 1) | ((kk & 8) >> 1), col = (S & 3) * 32 + (within & 3) * 8;
      voff[i] = k * LDK + col; } }
#define DMA_TILE(b, k0) do { _Pragma("unroll") for (int _i = 0; _i < 2; ++_i) { \
    __builtin_amdgcn_global_load_lds((const unsigned*)(Kh + (long)(k0) * LDK + koff[_i]), (LAS unsigned*)(TO_LAS(K_lds) + (b) * (int)SHM_K + (_i * 8 + wid) * 1024), 16, 0, 0); \
    __builtin_amdgcn_global_load_lds((const unsigned*)(Vh + (long)(k0) * LDK + voff[_i]), (LAS unsigned*)(TO_LAS(V_lds) + (b) * (int)SHM_V + (_i * 8 + wid) * 1024), 16, 0, 0); } } while (0)
  f32x16 pA0, pA1, pB0, pB1; bf16x8 pa0, pa1, pa2, pa3; const int NT = seq / KVBLK;
  int bc = 0, bn = 1, bw = 2;
  DMA_TILE(0, 0); DMA_TILE(1, KVBLK);
  hook();
  __syncthreads();
  qkt(pA0, pA1, K_lds, qr, r32, hi, init); expHalf(pA0);
#define ROT() do { const int _t = bc; bc = bn; bn = bw; bw = _t; } while (0)
#define ITER(PC0, PC1, PN0, PN1, t) do { __syncthreads(); \
    if ((t) + 2 < NT) DMA_TILE(bw, ((t) + 2) * KVBLK); \
    SBAR(); qkt(PN0, PN1, K_lds + bn * (int)SHM_K, qr, r32, hi, init); finishSM(PC0, PC1, l_reg, pa0, pa1, pa2, pa3); SBAR(); \
    pv_d0(o, vb0 + bc * (int)SHM_V, pa0, pa1, pa2, pa3); expHalf(PN0); ROT(); } while (0)
  for (int t = 0; t + 2 < NT; t += 2) { ITER(pA0, pA1, pB0, pB1, t); ITER(pB0, pB1, pA0, pA1, t + 1); }
  ITER(pA0, pA1, pB0, pB1, NT - 2);
  finishSM(pB0, pB1, l_reg, pa0, pa1, pa2, pa3); SBAR();
  pv_d0(o, vb0 + bc * (int)SHM_V, pa0, pa1, pa2, pa3);
#undef ITER
#undef ROT
#undef DMA_TILE
  if (hi == 0) li_l[r32] = l_reg; asm volatile("s_waitcnt lgkmcnt(0)" ::: "memory");
  __syncthreads();
  { char* ost = lds + wid * OST_WAVE;
#pragma unroll
    for (int r = 0; r < 16; ++r) { const int orow = crow(r, hi); const float rl = __builtin_amdgcn_rcpf(li_l[orow]);
#pragma unroll
      for (int d0 = 0; d0 < 4; ++d0) *(bf16_t*)(ost + orow * OST_PITCH + (d0 * 32 + r32) * 2) = (bf16_t)(cvt_pk_bf16(o[d0][r] * rl, 0.f) & 0xffffu); }
    asm volatile("s_waitcnt lgkmcnt(0)" ::: "memory");
#pragma unroll
    for (int i = 0; i < 8; ++i) { const int id = i * 64 + lane, row = id >> 4, cc = id & 15; const long grow = wid * QBLK + row;
      const u32x4 ov = *(const u32x4*)(ost + row * OST_PITCH + cc * 16); const u32x4 gv = *(const u32x4*)(GAb + grow * 1024 + cc * 8);
      u32x4 w;
#pragma unroll
      for (int q = 0; q < 4; ++q) w[q] = cvt_pk_bf16(bflo(ov[q]) * bflo(gv[q]), bfhi(ov[q]) * bfhi(gv[q]));
      *(u32x4*)(MIXb + grow * 2048 + cc * 8) = w; }
  }
  __syncthreads();
}
#undef KSWZ
#undef SBAR
}

__device__ __forceinline__ void p0_adaln(const float* __restrict__ c, const float* __restrict__ cctx, const float* __restrict__ wmod, float* part, LAS float* red,
                                         int tid, int wave, int lane, int bid, int G) {
    for (int it = bid; it < 192; it += G) {
        const int sl = it % 24, kc = it / 24, col = sl * 256 + 4 * lane, k0 = kc * 256 + wave * 32;
        f32x4 wv[32];
#pragma unroll
        for (int i = 0; i < 32; ++i) wv[i] = __builtin_nontemporal_load((const f32x4*)(wmod + (size_t)(k0 + i) * 6144 + col));
        f32x4 a0 = {0.f, 0.f, 0.f, 0.f}, a1 = a0, a2 = a0;
#pragma unroll
        for (int i = 0; i < 32; ++i) { const int k = k0 + i; a0 += silu_acc(c[k]) * wv[i]; a1 += silu_acc(c[DM + k]) * wv[i]; a2 += silu_acc(cctx[k]) * wv[i]; }
        *(LAS f32x4*)(red + ((wave * 3 + 0) * 64 + lane) * 4) = a0; *(LAS f32x4*)(red + ((wave * 3 + 1) * 64 + lane) * 4) = a1; *(LAS f32x4*)(red + ((wave * 3 + 2) * 64 + lane) * 4) = a2;
        __syncthreads();
        if (tid < 192) { const int r = tid >> 6, l = tid & 63; f32x4 sm = {0.f, 0.f, 0.f, 0.f};
#pragma unroll
            for (int w = 0; w < 8; ++w) sm += *(const LAS f32x4*)(red + ((w * 3 + r) * 64 + l) * 4);
            *(f32x4*)(part + ((size_t)kc * 3 + r) * 6144 + sl * 256 + 4 * l) = sm; }
        __syncthreads();
    }
}
template <bool PERMUTE>
__device__ __forceinline__ void p0_transpose_item(const float* __restrict__ W, int K, int N, bf16_t* WT, LAS float* scr, int item, int lane) {
    const int nblk = N / 32, kb = item / nblk, nb = item % nblk, k0 = 64 * kb, n0 = 32 * nb;
    const int srcc = PERMUTE ? win_src_col(n0 + (lane & 31)) : n0 + (lane & 31);
    float tv[32];
#pragma unroll
    for (int i = 0; i < 32; ++i) tv[i] = __builtin_nontemporal_load(W + (size_t)(k0 + 2 * i + (lane >> 5)) * N + srcc);
#pragma unroll
    for (int i = 0; i < 32; ++i) scr[(2 * i + (lane >> 5)) * 33 + (lane & 31)] = tv[i];
    LDS_WAIT(); asm volatile("" ::: "memory");
    const int cch = lane & 7;
#pragma unroll
    for (int j = 0; j < 4; ++j) { const int n = (lane >> 3) + 8 * j; const LAS float* s = scr + (8 * cch) * 33 + n;
        u32x4 o; o.x = cvt_pk_bf16(s[0 * 33], s[1 * 33]); o.y = cvt_pk_bf16(s[2 * 33], s[3 * 33]); o.z = cvt_pk_bf16(s[4 * 33], s[5 * 33]); o.w = cvt_pk_bf16(s[6 * 33], s[7 * 33]);
        *(u32x4*)(WT + (size_t)(n0 + n) * K + k0 + 8 * cch) = o; }
    LDS_WAIT(); asm volatile("" ::: "memory");
}
template <int MODE> __host__ __device__ __forceinline__ void tt_map(int T, int j, int& src, int& dst) {
    if (MODE == 1 || (T >= 5 && T <= 9)) { src = T * 256 + j; dst = j; return; }
    if (T <= 4) { src = T * 256 + j; const int hh = j >> 7, d = j & 127; const int sl = d < 32 ? 2 * d : d < 64 ? 2 * (d - 32) + 1 : d < 96 ? 2 * (d - 32) : 2 * (d - 64) + 1; dst = hh * 128 + sl; return; }
    const int ct = T - 10, r = j >> 6, c = j & 63; const int sec = r == 0 ? 3584 : r == 1 ? 4608 : r == 2 ? 2560 : 5632; src = sec + 64 * ct + c; dst = (r >> 1) * 128 + 2 * c + (r & 1);
}
constexpr int TT_PITCH = 144;
constexpr int TT_TILE_BYTES = 256 * TT_PITCH;
template <int MODE> __device__ __forceinline__ void tt_load(const float* __restrict__ W, int N, int kb, int T, int wave, int lane, f32x4 (&v)[8]) {
    int src, dst; tt_map<MODE>(T, 4 * lane, src, dst); (void)dst;
#pragma unroll
    for (int i = 0; i < 8; ++i) v[i] = __builtin_nontemporal_load((const f32x4*)(W + (size_t)(kb * 64 + wave * 8 + i) * N + src));
}
template <int MODE> __device__ __forceinline__ void tt_to_lds(LAS unsigned char* tile, int T, int wave, int lane, const f32x4 (&v)[8]) {
#pragma unroll
    for (int c = 0; c < 4; ++c) { int src, dst; tt_map<MODE>(T, 4 * lane + c, src, dst); (void)src;
        *(LAS u32x4*)(tile + dst * TT_PITCH + 16 * wave) = (u32x4){cvt_pk_bf16(v[0][c], v[1][c]), cvt_pk_bf16(v[2][c], v[3][c]), cvt_pk_bf16(v[4][c], v[5][c]), cvt_pk_bf16(v[6][c], v[7][c])}; }
}
__device__ __forceinline__ void tt_store(const LAS unsigned char* tile, bf16_t* WT, int K, int kb, int T, int tid) {
#pragma unroll
    for (int q = 0; q < 4; ++q) { const int id = q * NTHREADS + tid, n = id >> 3, cc = id & 7;
        *(u32x4*)(WT + (size_t)(T * 256 + n) * K + kb * 64 + 8 * cc) = *(const LAS u32x4*)(tile + n * TT_PITCH + 16 * cc); }
}
template <int MODE> __device__ __forceinline__ void tt_run(const float* __restrict__ W, int K, int N, bf16_t* WT, int NT, unsigned* queue, int first, int stride,
                                                          LAS unsigned char* tile, volatile LAS unsigned* word, int tid, int wave, int lane) {
    const int ntiles = (K / 64) * NT;
    if (tid == 0) *word = queue ? atomicAdd(queue, 1u) : (unsigned)first;
    __syncthreads();
    int it = (int)*word, nstat = first;
    f32x4 v[8];
    if (it < ntiles) tt_load<MODE>(W, N, it / NT, it % NT, wave, lane, v);
    __syncthreads();
    while (it < ntiles) {
        const int kb = it / NT, T = it % NT;
        tt_to_lds<MODE>(tile, T, wave, lane, v);
        nstat += stride;
        if (tid == 0) *word = queue ? atomicAdd(queue, 1u) : (unsigned)nstat;
        __syncthreads();
        const int nx = (int)*word;
        if (nx < ntiles) tt_load<MODE>(W, N, nx / NT, nx % NT, wave, lane, v);
        tt_store(tile, WT, K, kb, T, tid);
        __syncthreads();
        it = nx;
    }
}

template <int NR>
__device__ __forceinline__ void h_rows(const float* __restrict__ x0, bf16_t* o0, const LAS float* AL, const LAS float* SL, int lane) {
    f32x4 v[NR][8]; float rstd[NR];
#pragma unroll
    for (int r = 0; r < NR; ++r)
#pragma unroll
        for (int j = 0; j < 8; ++j) v[r][j] = ((const f32x4*)(x0 + (size_t)r * DM))[lane + 64 * j];
#pragma unroll
    for (int r = 0; r < NR; ++r) { float s = 0.f;
#pragma unroll
        for (int j = 0; j < 8; ++j) s += (v[r][j][0] * v[r][j][0] + v[r][j][1] * v[r][j][1]) + (v[r][j][2] * v[r][j][2] + v[r][j][3] * v[r][j][3]);
        rstd[r] = rsqrtf(wave_sum(s) * (1.f / DM) + EPS); }
#pragma unroll
    for (int j = 0; j < 8; ++j) { const f32x4 a = *(const LAS f32x4*)(AL + 4 * lane + 256 * j), sh = *(const LAS f32x4*)(SL + 4 * lane + 256 * j);
#pragma unroll
        for (int r = 0; r < NR; ++r) { const f32x4 h = v[r][j] * rstd[r] * a + sh;
            *(u32x2*)(o0 + (size_t)r * DM + 4 * lane + 256 * j) = (u32x2){cvt_pk_bf16(h[0], h[1]), cvt_pk_bf16(h[2], h[3])}; } }
}

#define XB_TMO      128
#define XB_XCNT(j)  (256  + 64 * (j))
#define XB_XSUB(j)  (1280 + 64 * (j))
#define XB_XGEN(j)  (2304 + 64 * (j))
#define XB_TOP      3328
#define XB_TOPGEN   3392
#define XCD_BAR_WORDS 3456
#define XB_SPIN_CAP (1u << 18)
__device__ __forceinline__ unsigned xb_ld(unsigned* p)              { return __hip_atomic_load(p, __ATOMIC_RELAXED, __HIP_MEMORY_SCOPE_AGENT); }
__device__ __forceinline__ unsigned xb_add(unsigned* p, unsigned v) { return __hip_atomic_fetch_add(p, v, __ATOMIC_RELAXED, __HIP_MEMORY_SCOPE_AGENT); }
__device__ __forceinline__ unsigned xb_xcc_id() { return (unsigned)__builtin_amdgcn_s_getreg((3 << 11) | 20) & 0xFu; }
#define XB_SPIN(cond, bar) do { unsigned _sp = 0; while (cond) { __builtin_amdgcn_s_sleep(1); \
    if ((++_sp & 255u) == 0u) { if (xb_ld(&(bar)[XB_TMO])) break; if (_sp > XB_SPIN_CAP) { atomicAdd(&(bar)[XB_TMO], 1u); break; } } } } while (0)
struct XcdBarrier { unsigned* bar; unsigned x; volatile LAS unsigned* st; };
__device__ __forceinline__ XcdBarrier xcd_barrier_post(unsigned* bar, volatile LAS unsigned* st, bool leader) {
    XcdBarrier b; b.bar = bar; b.x = xb_xcc_id(); b.st = st;
    if (leader) (void)xb_add(&bar[XB_XCNT(b.x)], 1u);
    return b;
}
__device__ __forceinline__ void xcd_barrier_complete(unsigned* bar, unsigned x, unsigned& nloc, unsigned& nx) {
    const unsigned G = gridDim.x * gridDim.y * gridDim.z;
    unsigned sum, cnt, mine, sp = 0u;
    for (;;) {
        sum = 0u; cnt = 0u; mine = 0u;
#pragma unroll
        for (unsigned j = 0; j < 16; ++j) { const unsigned c = xb_ld(&bar[XB_XCNT(j)]); sum += c; cnt += (c > 0u) ? 1u : 0u; mine = (j == x) ? c : mine; }
        if (sum == G) break;
        __builtin_amdgcn_s_sleep(1);
        if ((++sp & 255u) == 0u) { if (xb_ld(&bar[XB_TMO])) break; if (sp > XB_SPIN_CAP) { atomicAdd(&bar[XB_TMO], 1u); break; } }
    }
    nloc = mine > 0u ? mine : 1u; nx = cnt > 0u ? cnt : 1u;
}
__device__ __forceinline__ void xcd_barrier(const XcdBarrier& b, bool leader) {
    asm volatile("s_waitcnt vmcnt(0)" ::: "memory");
    __syncthreads();
    if (leader) {
        unsigned* bar = b.bar;
        __builtin_amdgcn_s_waitcnt(0);
        unsigned nloc = b.st[0], nx = b.st[1];
        if (nloc == 0u) { xcd_barrier_complete(bar, b.x, nloc, nx); b.st[0] = nloc; b.st[1] = nx; }
        const unsigned old = xb_add(&bar[XB_XSUB(b.x)], 1u);
        const unsigned gen = old / nloc;
        if (old + 1u == (gen + 1u) * nloc) {
            __builtin_amdgcn_fence(__ATOMIC_RELEASE, "agent");
            asm volatile("s_waitcnt vmcnt(0)" ::: "memory");
            const unsigned og = xb_add(&bar[XB_TOP], 1u);
            const unsigned tg = og / nx;
            if (og + 1u == (tg + 1u) * nx) xb_add(&bar[XB_TOPGEN], 1u);
            else XB_SPIN(xb_ld(&bar[XB_TOPGEN]) == tg, bar);
            __builtin_amdgcn_fence(__ATOMIC_ACQUIRE, "agent");
            xb_add(&bar[XB_XGEN(b.x)], 1u);
            asm volatile("s_waitcnt vmcnt(0)" ::: "memory");
        } else {
            XB_SPIN(xb_ld(&bar[XB_XGEN(b.x)]) == gen, bar);
            __builtin_amdgcn_fence(__ATOMIC_ACQUIRE, "agent");
            asm volatile("s_waitcnt vmcnt(0)" ::: "memory");
        }
    }
    __syncthreads();
}

struct Args {
    const float *x, *c, *ctx, *cctx, *wmod, *bmod, *normg, *win, *qg, *kg, *convw, *wout, *fg;
    float* out; unsigned char* ws;
    int use_cg, pad;
};

__global__ void __launch_bounds__(NTHREADS, 2) fwd_megakernel(Args a) {
    extern __shared__ __attribute__((aligned(16))) unsigned char lds_raw[];
    cg::grid_group grid = cg::this_grid();
    LAS unsigned char* lds = (LAS unsigned char*)lds_raw;
    const int bid = blockIdx.x, G = gridDim.x;
    const int wave_s = __builtin_amdgcn_readfirstlane(threadIdx.x >> 6);
    const bool leader = (threadIdx.x == 0);
    volatile LAS unsigned* MISC = (volatile LAS unsigned*)(lds + MISC_OFF);
    if (threadIdx.x < 4) MISC[threadIdx.x] = 0u;
    __syncthreads();
    const XcdBarrier xbar = xcd_barrier_post((unsigned*)(a.ws + WS_BAR), MISC, leader);
#define GRID_SEAM() do { if (a.use_cg) grid.sync(); else xcd_barrier(xbar, threadIdx.x == 0); } while (0)
#define PHASE_IDS() const int tid = opaque_tid(wave_s), lane = tid & 63, wave = wave_s; (void)lane; (void)wave
    unsigned char* ws = a.ws;
    float* PART = (float*)(ws + WS_PART); float* GATE = (float*)(ws + WS_GATE); float* SSQ = (float*)(ws + WS_SSQ);
    bf16_t* WIN = (bf16_t*)(ws + WS_WIN); bf16_t* WOUT = (bf16_t*)(ws + WS_WOUT); bf16_t* H = (bf16_t*)(ws + WS_H);
    bf16_t* Qb = (bf16_t*)(ws + WS_Q); bf16_t* KB = (bf16_t*)(ws + WS_K); bf16_t* VB = (bf16_t*)(ws + WS_V);
    bf16_t* GA = (bf16_t*)(ws + WS_GA); bf16_t* Ub = (bf16_t*)(ws + WS_U); bf16_t* Gb = (bf16_t*)(ws + WS_G); bf16_t* MIX = (bf16_t*)(ws + WS_MIX);

    {
        PHASE_IDS();
        p0_adaln(a.c, a.cctx, a.wmod, PART, (LAS float*)lds, tid, wave, lane, bid, G);
        tt_run<0>(a.win, DM, NIN, WIN, NIN / 256, (unsigned*)(ws + WS_BAR) + TT_QUEUE_WORD, 0, 0, lds + 32768, (volatile LAS unsigned*)(lds + XCH_OFF), tid, wave, lane);
    }
    GRID_SEAM();

    {
        PHASE_IDS();
        LAS float* AL0 = (LAS float*)lds; LAS float* SL0 = AL0 + DM; LAS float* AL2 = SL0 + DM; LAS float* SL2 = AL2 + DM;
        for (int idx = bid * NTHREADS + tid; idx < NB * DM; idx += G * NTHREADS) { const int r = idx >> 11, n = (idx & (DM - 1)) + 2 * DM; float s = a.bmod[n];
#pragma unroll
            for (int kc = 0; kc < 8; ++kc) s += PART[((size_t)kc * 3 + r) * 6144 + n];
            GATE[idx] = s; }
        for (int ch = bid; ch < MLAT / 32; ch += G) {
            const int r = ch >> 7;
            __syncthreads();
            { const int n4 = 4 * tid;
                f32x4 sh0 = *(const f32x4*)(a.bmod + n4), sc0 = *(const f32x4*)(a.bmod + DM + n4), sh2 = sh0, sc2 = sc0;
#pragma unroll
                for (int kc = 0; kc < 8; ++kc) { const float* p = PART + (size_t)kc * 3 * 6144;
                    sh0 += *(const f32x4*)(p + r * 6144 + n4); sc0 += *(const f32x4*)(p + r * 6144 + DM + n4); sh2 += *(const f32x4*)(p + 2 * 6144 + n4); sc2 += *(const f32x4*)(p + 2 * 6144 + DM + n4); }
                const f32x4 gn = *(const f32x4*)(a.normg + n4);
                *(LAS f32x4*)(AL0 + n4) = gn * (1.f + sc0); *(LAS f32x4*)(SL0 + n4) = sh0; *(LAS f32x4*)(AL2 + n4) = gn * (1.f + sc2); *(LAS f32x4*)(SL2 + n4) = sh2;
            }
            __syncthreads();
            { const int m = ch * 32 + wave * 4; h_rows<4>(a.x + (size_t)m * DM, H + (size_t)m * DM, AL0, SL0, lane); }
            if (wave < 2) { const int mc = ch * 2 + wave; if (mc < MCTX) h_rows<1>(a.ctx + (size_t)mc * DM, H + (size_t)(MLAT + mc) * DM, AL2, SL2, lane); }
        }
        __syncthreads();
    }
    GRID_SEAM();

    {
        typedef pg8::TileMap<MLAT / 256, NIN / 256, 4, 32, 4, 2> MapIn;
        const int Rfull = MapIn::ntot / G, tail = MapIn::ntot - Rfull * G; const bool split = (2 * tail <= G);
        pg8::Gemm g{H, WIN, MALL, NIN, DM};
        EpiIn E{ws, a.qg, a.kg, a.convw, (LAS float*)(lds + XCH_OFF)};
        const bool has_tail = split && bid < 2 * tail;
        pg8::Unit tu; tu.pm = 0; tu.pn = 0; if (has_tail) MapIn::decode(Rfull * G + (bid >> 1), tu);
        { pg8::StaticOrder<MapIn> S; S.init(G, bid, split ? Rfull * G : MapIn::ntot);
          if (has_tail) pg8::gemm_phase<EpiIn, pg8::StaticOrder<MapIn>, -1, true, false>(lds, g, S, E, wave_s, &tu);
          else          pg8::gemm_phase<EpiIn, pg8::StaticOrder<MapIn>, -1>(lds, g, S, E, wave_s); }
        if (has_tail) { pg8::OneUnit<MapIn> S1{Rfull * G + (bid >> 1)};
            if (bid & 1) pg8::gemm_phase<EpiIn, pg8::OneUnit<MapIn>, 1, false, true>(lds, g, S1, E, wave_s);
            else         pg8::gemm_phase<EpiIn, pg8::OneUnit<MapIn>, 0, false, true>(lds, g, S1, E, wave_s); }
        { PHASE_IDS();
          const int first_idle = (2 * tail <= G) ? 2 * tail : tail, n_idle = first_idle == 0 ? G : G - first_idle, me = first_idle == 0 ? bid : bid - first_idle;
          if (me >= 0) tt_run<1>(a.wout, DM, DM, WOUT, DM / 256, nullptr, me, n_idle, lds + 32768, (volatile LAS unsigned*)(lds + XCH_OFF), tid, wave, lane); }
    }
    GRID_SEAM();

    {
        PHASE_IDS();
        if (bid < 256) {
            const int ui = bid;
            const int xq = ui & 7, idx = (ui >> 3) + 32 * (xq & 1), combo = xq >> 1, b = combo >> 1, kvh = combo & 1, h = kvh * 4 + (idx >> 4), qb = idx & 15;
            const size_t row0 = (size_t)b * SEQ + qb * 256;
            att::attn_dense_body(Qb + row0 * AW + h * HD, KB + (size_t)b * SKV * 256 + kvh * HD, VB + (size_t)b * SKV * 256 + kvh * HD,
                                 GA + row0 * AW + h * HD, MIX + row0 * DM + h * HD, a.qg, a.kg, SKV, (char*)lds_raw, wave_s,
                                 ConvFixHook{Ub, Gb, a.convw, MIX, bid < MLAT / 64 ? bid : -1, tid});
        }
    }
    GRID_SEAM();

    {
        typedef pg8::TileMap<MLAT / 256, DM / 256> MapOut;
        pg8::Gemm g{MIX, WOUT, MLAT, DM, DM}; pg8::OneUnit<MapOut> S{bid < MapOut::ntot ? bid : -1};
        EpiOut E{a.x, a.fg, a.out, ws};
        pg8::gemm_phase<EpiOut, pg8::OneUnit<MapOut>, -1>(lds, g, S, E, wave_s);
    }
}

extern "C" void kernel_launch(void* const* d_in, const int* in_sizes, int n_in, void* d_out, int out_size, void* d_ws, size_t ws_size, hipStream_t stream) {
    static int grid_blocks = 0;
    if (grid_blocks == 0) {
        if (n_in != 13 || in_sizes[0] != MLAT * DM || out_size != MLAT * DM || ws_size < WS_END) { fprintf(stderr, "kernel_launch: shape mismatch (n_in %d in0 %d out %d ws %zu)\n", n_in, n_in > 0 ? in_sizes[0] : -1, out_size, ws_size); grid_blocks = -1; return; }
        int dev = 0, cus = 0, per_cu = 0;
        hipGetDevice(&dev);
        hipDeviceGetAttribute(&cus, hipDeviceAttributeMultiprocessorCount, dev);
        if (hipFuncSetAttribute((const void*)fwd_megakernel, hipFuncAttributeMaxDynamicSharedMemorySize, LDS_BYTES) != hipSuccess) { fprintf(stderr, "kernel_launch: hipFuncSetAttribute failed\n"); grid_blocks = -1; return; }
        if (hipOccupancyMaxActiveBlocksPerMultiprocessor(&per_cu, (const void*)fwd_megakernel, NTHREADS, LDS_BYTES) != hipSuccess || per_cu < 1) { fprintf(stderr, "kernel_launch: occupancy query gave %d\n", per_cu); per_cu = 1; }
        (void)hipGetLastError();
        grid_blocks = cus * per_cu;
        if (grid_blocks > 256) grid_blocks = 256;
    }
    if (grid_blocks < 0) return;
    Args a{};
    a.x = (const float*)d_in[0]; a.c = (const float*)d_in[1]; a.ctx = (const float*)d_in[2]; a.cctx = (const float*)d_in[3];
    a.wmod = (const float*)d_in[4]; a.bmod = (const float*)d_in[5]; a.normg = (const float*)d_in[6]; a.win = (const float*)d_in[7];
    a.qg = (const float*)d_in[8]; a.kg = (const float*)d_in[9]; a.convw = (const float*)d_in[10]; a.wout = (const float*)d_in[11]; a.fg = (const float*)d_in[12];
    a.out = (float*)d_out; a.ws = (unsigned char*)d_ws; a.use_cg = 0; a.pad = 0;
    if (hipMemsetAsync((char*)d_ws + WS_BAR, 0, CTL_BYTES, stream) != hipSuccess) { fprintf(stderr, "kernel_launch: hipMemsetAsync failed\n"); return; }
    void* args[] = {&a};
    hipError_t e = hipLaunchCooperativeKernel((const void*)fwd_megakernel, dim3(grid_blocks), dim3(NTHREADS), args, LDS_BYTES, stream);
    if (e != hipSuccess) fprintf(stderr, "cooperative launch failed: %s (grid %d)\n", hipGetErrorString(e), grid_blocks);
}
```
